# Optimizing an MI355X kernel written in HIP

```python
import math
import jax, jax.numpy as jnp
from jax import lax
import numpy as np

D_MODEL = 1024
BATCH = 16
SEQ = 2048
DEPTH = 4

GRID_W = 64
CTX_LEN = 256
N_MIXERS = 3
Q_BLOCK = 128
ROPE_THETA = 10000.0
LN_EPS = 1e-5
RMS_EPS = 1e-6
D_FF = 4 * D_MODEL

MLA_HEADS = 8
MLA_Q_RANK = 512
MLA_KV_RANK = 256
MLA_NOPE = 128
MLA_ROPE = 64
MLA_V = 128

NA_HEADS = 16
NA_HEAD_DIM = D_MODEL // NA_HEADS
NA_WIN_ROWS = 8
NA_WIN_COLS = 16

GQA_HEAD_DIM = 128
GQA_Q_HEADS = D_MODEL // GQA_HEAD_DIM
GQA_KV_HEADS = GQA_Q_HEADS // 4
GQA_GROUP = GQA_Q_HEADS // GQA_KV_HEADS

kernel_name = "hybrid_mla_na_gqa_dit_trunk"


def _layer_norm(x, g, b):
    xf = x.astype(jnp.float32)
    mu = jnp.mean(xf, -1, keepdims=True)
    var = jnp.mean(jnp.square(xf - mu), -1, keepdims=True)
    return ((xf - mu) * lax.rsqrt(var + LN_EPS) * g + b).astype(x.dtype)


def _rms_norm(x, g):
    xf = x.astype(jnp.float32)
    return (xf * lax.rsqrt(jnp.mean(xf * xf, -1, keepdims=True) + RMS_EPS) * g).astype(x.dtype)


def _rope_1d(x, pos):
    half = x.shape[-1] // 2
    freqs = ROPE_THETA ** (-jnp.arange(half, dtype=jnp.float32) / half)
    ang = pos.astype(jnp.float32)[:, None, None] * freqs
    cos, sin = jnp.cos(ang), jnp.sin(ang)
    xf = x.astype(jnp.float32)
    x1, x2 = xf[..., :half], xf[..., half:]
    return jnp.concatenate([x1 * cos - x2 * sin, x1 * sin + x2 * cos], -1).astype(x.dtype)


def _rope_2d(x, rows, cols):
    h = x.shape[-1] // 2
    return jnp.concatenate([_rope_1d(x[..., :h], rows), _rope_1d(x[..., h:], cols)], -1)


def _grid_positions(s):
    t = jnp.arange(s, dtype=jnp.int32)
    return t // GRID_W, t % GRID_W


def _block_attention(q, k, v, scale):
    b, sq, hk, g, dk = q.shape
    nb = sq // Q_BLOCK
    qb = q.reshape(b, nb, Q_BLOCK, hk, g, dk).transpose(1, 0, 2, 3, 4, 5)

    def step(qi):
        s = jnp.einsum('bqhgd,bkhd->bhgqk', qi, k).astype(jnp.float32) * scale
        p = jax.nn.softmax(s, axis=-1).astype(v.dtype)
        return jnp.einsum('bhgqk,bkhd->bqhgd', p, v)

    o = lax.map(step, qb)
    return o.transpose(1, 0, 2, 3, 4, 5).reshape(b, sq, hk * g * v.shape[-1])


def _mla_q(h, w_dq, q_norm, w_uq, rows, cols):
    b, s, _ = h.shape
    q = (_rms_norm(h @ w_dq, q_norm) @ w_uq).reshape(b, s, MLA_HEADS, MLA_NOPE + MLA_ROPE)
    q_nope, q_pe = q[..., :MLA_NOPE], q[..., MLA_NOPE:]
    if rows is not None:
        q_pe = _rope_2d(q_pe, rows, cols)
    return jnp.concatenate([q_nope, q_pe], -1)


def _mla_kv(h, w_dkv, kv_norm, w_ukv, rows, cols):
    b, s, _ = h.shape
    ckv = h @ w_dkv
    c_kv, k_pe = ckv[..., :MLA_KV_RANK], ckv[..., MLA_KV_RANK:]
    kv = (_rms_norm(c_kv, kv_norm) @ w_ukv).reshape(b, s, MLA_HEADS, MLA_NOPE + MLA_V)
    k_nope, v = kv[..., :MLA_NOPE], kv[..., MLA_NOPE:]
    k_pe = k_pe[:, :, None, :]
    if rows is not None:
        k_pe = _rope_2d(k_pe, rows, cols)
    k = jnp.concatenate([k_nope, jnp.broadcast_to(k_pe, (b, s, MLA_HEADS, MLA_ROPE))], -1)
    return k, v


def _mla_mixer(h, hc, w_dq, q_norm, w_uq, w_dkv, kv_norm, w_ukv, w_o, need_ctx):
    rows, cols = _grid_positions(h.shape[1])
    scale = (MLA_NOPE + MLA_ROPE) ** -0.5
    q = _mla_q(h, w_dq, q_norm, w_uq, rows, cols)
    k, v = _mla_kv(h, w_dkv, kv_norm, w_ukv, rows, cols)
    kc, vc = _mla_kv(hc, w_dkv, kv_norm, w_ukv, None, None)
    k_all = jnp.concatenate([kc, k], 1)
    v_all = jnp.concatenate([vc, v], 1)
    out = _block_attention(q[:, :, :, None], k_all, v_all, scale) @ w_o
    out_c = None
    if need_ctx:
        qc = _mla_q(hc, w_dq, q_norm, w_uq, None, None)
        out_c = _block_attention(qc[:, :, :, None], kc, vc, scale) @ w_o
    return out, out_c


def _na_mixer(h, hc, w_qkv, b_qkv, rpb, w_o, need_ctx):
    b, s, _ = h.shape
    n_rows = s // GRID_W
    kr = min(NA_WIN_ROWS, n_rows)
    scale = NA_HEAD_DIM ** -0.5

    def proj(t):
        qkv = (t @ w_qkv + b_qkv).reshape(t.shape[0], t.shape[1], 3, NA_HEADS, NA_HEAD_DIM)
        return qkv[:, :, 0], qkv[:, :, 1], qkv[:, :, 2]

    q, k, v = proj(h)
    qc, kc, vc = proj(hc)
    grid = (b, n_rows, GRID_W, NA_HEADS, NA_HEAD_DIM)
    q_grid, k_grid, v_grid = q.reshape(grid), k.reshape(grid), v.reshape(grid)

    r_idx = jnp.arange(n_rows, dtype=jnp.int32)
    row_start = jnp.clip(r_idx - kr // 2, 0, n_rows - kr)
    c_idx = jnp.arange(GRID_W, dtype=jnp.int32)
    col_start = jnp.clip(c_idx - NA_WIN_COLS // 2, 0, GRID_W - NA_WIN_COLS)
    col_valid = (c_idx[None, :] >= col_start[:, None]) & (c_idx[None, :] < col_start[:, None] + NA_WIN_COLS)
    mask = jnp.tile(col_valid, (1, kr))
    dc = jnp.clip(c_idx[None, :] - c_idx[:, None] + NA_WIN_COLS - 1, 0, 2 * NA_WIN_COLS - 2)
    rpb_cols = rpb[:, :, dc]

    def row_step(args):
        r, rs = args
        q_row = lax.dynamic_index_in_dim(q_grid, r, axis=1, keepdims=False)
        k_strip = lax.dynamic_slice_in_dim(k_grid, rs, kr, axis=1).reshape(b, kr * GRID_W, NA_HEADS, NA_HEAD_DIM)
        v_strip = lax.dynamic_slice_in_dim(v_grid, rs, kr, axis=1).reshape(b, kr * GRID_W, NA_HEADS, NA_HEAD_DIM)
        dr = rs + jnp.arange(kr, dtype=jnp.int32) - r + NA_WIN_ROWS - 1
        bias = jnp.take(rpb_cols, dr, axis=1).transpose(0, 2, 1, 3).reshape(NA_HEADS, GRID_W, kr * GRID_W)
        s_lat = jnp.einsum('bqhd,bkhd->bhqk', q_row, k_strip).astype(jnp.float32) * scale + bias
        s_lat = jnp.where(mask, s_lat, -jnp.inf)
        s_ctx = jnp.einsum('bqhd,bkhd->bhqk', q_row, kc).astype(jnp.float32) * scale
        p = jax.nn.softmax(jnp.concatenate([s_ctx, s_lat], -1), axis=-1).astype(v.dtype)
        return jnp.einsum('bhqk,bkhd->bqhd', p, jnp.concatenate([vc, v_strip], 1))

    o = lax.map(row_step, (r_idx, row_start))
    out = o.transpose(1, 0, 2, 3, 4).reshape(b, s, NA_HEADS * NA_HEAD_DIM) @ w_o
    out_c = None
    if need_ctx:
        out_c = _block_attention(qc[:, :, :, None], kc, vc, scale) @ w_o
    return out, out_c


def _gqa_proj(t, w_qkv, q_norm, k_norm, rows, cols):
    bb, ss, _ = t.shape
    nq = GQA_Q_HEADS * GQA_HEAD_DIM
    nk = GQA_KV_HEADS * GQA_HEAD_DIM
    qkv = t @ w_qkv
    q = _rms_norm(qkv[..., :nq].reshape(bb, ss, GQA_Q_HEADS, GQA_HEAD_DIM), q_norm)
    k = _rms_norm(qkv[..., nq:nq + nk].reshape(bb, ss, GQA_KV_HEADS, GQA_HEAD_DIM), k_norm)
    v = qkv[..., nq + nk:].reshape(bb, ss, GQA_KV_HEADS, GQA_HEAD_DIM)
    if rows is not None:
        q = _rope_2d(q, rows, cols)
        k = _rope_2d(k, rows, cols)
    return q.reshape(bb, ss, GQA_KV_HEADS, GQA_GROUP, GQA_HEAD_DIM), k, v


def _gqa_mixer(h, hc, w_qkv, q_norm, k_norm, w_o, need_ctx):
    rows, cols = _grid_positions(h.shape[1])
    scale = GQA_HEAD_DIM ** -0.5
    q, k, v = _gqa_proj(h, w_qkv, q_norm, k_norm, rows, cols)
    qc, kc, vc = _gqa_proj(hc, w_qkv, q_norm, k_norm, None, None)
    out = _block_attention(q, jnp.concatenate([kc, k], 1), jnp.concatenate([vc, v], 1), scale) @ w_o
    out_c = None
    if need_ctx:
        out_c = _block_attention(qc, kc, vc, scale) @ w_o
    return out, out_c


def _mlp(h, w1, w2):
    return jnp.square(jax.nn.relu(h @ w1)) @ w2


def setup_inputs(seed: int = 0) -> dict:
    key = jax.random.key(seed)
    ks = iter(jax.random.split(key, 32))
    beta = (8.0 * DEPTH) ** -0.25
    n_a = len(range(0, DEPTH, N_MIXERS))
    n_b = len(range(1, DEPTH, N_MIXERS))
    n_c = len(range(2, DEPTH, N_MIXERS))
    D = D_MODEL

    def nrm(shape, s=1.0):
        return jax.random.normal(next(ks), shape, jnp.float32) * s

    def w(shape, fan_in, g=1.0):
        return nrm(shape, g * fan_in ** -0.5)

    def gain(shape):
        return 1.0 + nrm(shape, 0.05)

    return {
        "x": nrm((BATCH, SEQ, D)),
        "c": nrm((BATCH, D)),
        "ctx": nrm((BATCH, CTX_LEN, D)),
        "c_ctx": nrm((D,)),
        "ada_w": w((DEPTH, D, 6 * D), D),
        "ada_b": nrm((DEPTH, 6 * D), 0.02),
        "ln1_g": gain((DEPTH, D)),
        "ln1_b": nrm((DEPTH, D), 0.02),
        "ln2_g": gain((DEPTH, D)),
        "ln2_b": nrm((DEPTH, D), 0.02),
        "mlp_w1": w((DEPTH, D, D_FF), D),
        "mlp_w2": w((DEPTH, D_FF, D), D_FF, beta),
        "mla_w_dq": w((n_a, D, MLA_Q_RANK), D),
        "mla_q_norm": gain((n_a, MLA_Q_RANK)),
        "mla_w_uq": w((n_a, MLA_Q_RANK, MLA_HEADS * (MLA_NOPE + MLA_ROPE)), MLA_Q_RANK),
        "mla_w_dkv": w((n_a, D, MLA_KV_RANK + MLA_ROPE), D),
        "mla_kv_norm": gain((n_a, MLA_KV_RANK)),
        "mla_w_ukv": w((n_a, MLA_KV_RANK, MLA_HEADS * (MLA_NOPE + MLA_V)), MLA_KV_RANK),
        "mla_w_o": w((n_a, MLA_HEADS * MLA_V, D), MLA_HEADS * MLA_V, beta),
        "na_w_qkv": w((n_b, D, 3 * NA_HEADS * NA_HEAD_DIM), D),
        "na_b_qkv": nrm((n_b, 3 * NA_HEADS * NA_HEAD_DIM), 0.02),
        "na_rpb": nrm((n_b, NA_HEADS, 2 * NA_WIN_ROWS - 1, 2 * NA_WIN_COLS - 1), 0.1),
        "na_w_o": w((n_b, NA_HEADS * NA_HEAD_DIM, D), NA_HEADS * NA_HEAD_DIM, beta),
        "gqa_w_qkv": w((n_c, D, (GQA_Q_HEADS + 2 * GQA_KV_HEADS) * GQA_HEAD_DIM), D),
        "gqa_q_norm": gain((n_c, GQA_HEAD_DIM)),
        "gqa_k_norm": gain((n_c, GQA_HEAD_DIM)),
        "gqa_w_o": w((n_c, GQA_Q_HEADS * GQA_HEAD_DIM, D), GQA_Q_HEADS * GQA_HEAD_DIM, beta),
    }


def reference(x, c, ctx, c_ctx, ada_w, ada_b, ln1_g, ln1_b, ln2_g, ln2_b, mlp_w1, mlp_w2,
              mla_w_dq, mla_q_norm, mla_w_uq, mla_w_dkv, mla_kv_norm, mla_w_ukv, mla_w_o,
              na_w_qkv, na_b_qkv, na_rpb, na_w_o,
              gqa_w_qkv, gqa_q_norm, gqa_k_norm, gqa_w_o):
    alpha = (2.0 * DEPTH) ** 0.25
    for i in range(DEPTH):
        kind, j = i % N_MIXERS, i // N_MIXERS
        need_ctx = i < DEPTH - 1
        mod = (jax.nn.silu(c) @ ada_w[i] + ada_b[i])[:, None, :]
        mod_c = jax.nn.silu(c_ctx) @ ada_w[i] + ada_b[i]
        sh1, sc1, g1, sh2, sc2, g2 = jnp.split(mod, 6, axis=-1)
        csh1, csc1, cg1, csh2, csc2, cg2 = jnp.split(mod_c, 6, axis=-1)

        h = x * (1 + sc1) + sh1
        hc = ctx * (1 + csc1) + csh1
        if kind == 0:
            y, yc = _mla_mixer(h, hc, mla_w_dq[j], mla_q_norm[j], mla_w_uq[j], mla_w_dkv[j],
                               mla_kv_norm[j], mla_w_ukv[j], mla_w_o[j], need_ctx)
        elif kind == 1:
            y, yc = _na_mixer(h, hc, na_w_qkv[j], na_b_qkv[j], na_rpb[j], na_w_o[j], need_ctx)
        else:
            y, yc = _gqa_mixer(h, hc, gqa_w_qkv[j], gqa_q_norm[j], gqa_k_norm[j], gqa_w_o[j], need_ctx)
        x = _layer_norm(alpha * x + g1 * y, ln1_g[i], ln1_b[i])
        if need_ctx:
            ctx = _layer_norm(alpha * ctx + cg1 * yc, ln1_g[i], ln1_b[i])

        x = _layer_norm(alpha * x + g2 * _mlp(x * (1 + sc2) + sh2, mlp_w1[i], mlp_w2[i]), ln2_g[i], ln2_b[i])
        if need_ctx:
            ctx = _layer_norm(alpha * ctx + cg2 * _mlp(ctx * (1 + csc2) + csh2, mlp_w1[i], mlp_w2[i]),
                              ln2_g[i], ln2_b[i])
    return x
```

```cpp
#include <hip/hip_runtime.h>
#include <hip/hip_cooperative_groups.h>
#include <cstdio>
#include <cstdint>
namespace cg = cooperative_groups;
namespace pg8 {
#define PG8_LAS __attribute__((address_space(3)))
typedef unsigned short bf16_t;
typedef short bf16x8 __attribute__((ext_vector_type(8)));
typedef float f32x4 __attribute__((ext_vector_type(4)));
typedef unsigned u32x4 __attribute__((ext_vector_type(4)));
constexpr int BM = 256, BK = 64, HALF = 128, HTB = HALF * BK * 2  , STAGE_BYTES = 8 * HTB, NXCD = 8, WGM = 8;

__host__ __device__ __forceinline__ int lds_byte(int r, int c) { const int st = (r >> 4) * 2 + (c >> 5), rr = r & 15, cc = c & 31, ob = rr * 64 + cc * 2; return st * 1024 + (ob ^ (((ob >> 9) & 1) << 5)); }
__host__ __device__ __forceinline__ void stage_rc(int b, int& R, int& C) { const int st = b / 1024, sb = b % 1024, swz = sb ^ (((sb >> 9) & 1) << 5); R = (st >> 1) * 16 + swz / 64; C = (st & 1) * 32 + (swz % 64) / 2; }
__host__ __device__ __forceinline__ int perm32(int rho) { const int n = rho >> 4, i = rho & 15; return 8 * (i >> 2) + 4 * n + (i & 3); }

struct Unit { int pm, pn; };
struct Gemm { const bf16_t* A; int lda; const bf16_t* Bt; int M, N, K; };

struct StaticOrder {
    int nM, nN, nwg, G, c;
    __host__ __device__ void init(int M, int N, int G_, int c_) { nM = M / BM; nN = N / BM; nwg = nM * nN; G = G_; c = c_; }
    __host__ __device__ bool next(int i, Unit& u) const {
        const long L = (long)i * G + c; if (L >= nwg) return false;
        int wgid = (int)L; { const int q = nwg / NXCD, r = nwg % NXCD, xcd = wgid % NXCD, off = wgid / NXCD; wgid = (xcd < r ? xcd * (q + 1) : r * (q + 1) + (xcd - r) * q) + off; }
        const int nig = WGM * nN, gid = wgid / nig, fm = gid * WGM, gsz = (nM - fm) < WGM ? (nM - fm) : WGM;
        u.pm = fm + ((wgid % nig) % gsz); u.pn = (wgid % nig) / gsz; return true;
    }
    __device__ __forceinline__ void a_ready(const Unit&) const {}
    __device__ __forceinline__ void done(const Unit&) const {}
};

typedef float f32x2 __attribute__((ext_vector_type(2)));
typedef __bf16 bf16x2_t __attribute__((ext_vector_type(2)));
__device__ __forceinline__ unsigned cvt_pk_bf16(float lo, float hi) { f32x2 v = {lo, hi}; bf16x2_t b = __builtin_convertvector(v, bf16x2_t); return __builtin_bit_cast(unsigned, b); }

struct EpiBf16 {
    static constexpr bool PERM = true, AFTER_DRAIN = false;
    bf16_t* O; int ldc; const float* bias; int act;
    __device__ __forceinline__ void operator()(const f32x4 (&acc)[2][2][4][2], const Unit& u, int wr, int wc, int fr, int fq) const {
        const int row0 = u.pm * BM + wr * 64 + fr; const int col0 = u.pn * BM + wc * 32 + 8 * fq;
        f32x4 bv[2][2];
#pragma unroll
        for (int bj = 0; bj < 2; ++bj)
#pragma unroll
            for (int n = 0; n < 2; ++n) bv[bj][n] = bias ? *(const f32x4*)(bias + col0 + bj * HALF + 4 * n) : (f32x4){0.f, 0.f, 0.f, 0.f};
#pragma unroll
        for (int ai = 0; ai < 2; ++ai)
#pragma unroll
            for (int m = 0; m < 4; ++m) { bf16_t* rowp = O + (size_t)(row0 + ai * HALF + m * 16) * ldc + col0;
#pragma unroll
                for (int bj = 0; bj < 2; ++bj) { f32x4 v0 = acc[ai][bj][m][0] + bv[bj][0], v1 = acc[ai][bj][m][1] + bv[bj][1];
                    if (act) {
#pragma unroll
                        for (int j = 0; j < 4; ++j) { float a = v0[j] > 0.f ? v0[j] : 0.f, b = v1[j] > 0.f ? v1[j] : 0.f; v0[j] = a * a; v1[j] = b * b; } }
                    u32x4 w; w.x = cvt_pk_bf16(v0[0], v0[1]); w.y = cvt_pk_bf16(v0[2], v0[3]); w.z = cvt_pk_bf16(v1[0], v1[1]); w.w = cvt_pk_bf16(v1[2], v1[3]);
                    *(u32x4*)(rowp + bj * HALF) = w; } }
    }
};
struct EpiResid {
    static constexpr bool PERM = false, AFTER_DRAIN = false;
    float* xlat; float* xctx; const float* gate; float alpha;
    __device__ __forceinline__ void operator()(const f32x4 (&acc)[2][2][4][2], const Unit& u, int wr, int wc, int fr, int fq) const {
        const int col0 = u.pn * BM + wc * 32 + 4 * fq;
        const int midx = u.pm < 128 ? (u.pm >> 3) : 16;
        float* xb = u.pm < 128 ? xlat + (size_t)u.pm * BM * 1024 : xctx + (size_t)(u.pm - 128) * BM * 1024;
        const float* gp = gate + (size_t)midx * 6144 + col0;
        f32x4 gv[2][2];
#pragma unroll
        for (int bj = 0; bj < 2; ++bj)
#pragma unroll
            for (int n = 0; n < 2; ++n) gv[bj][n] = *(const f32x4*)(gp + bj * HALF + n * 16);
#pragma unroll
        for (int ai = 0; ai < 2; ++ai)
#pragma unroll
            for (int m = 0; m < 4; ++m) { float* rowp = xb + (size_t)(wr * 64 + fr + ai * HALF + m * 16) * 1024 + col0;
#pragma unroll
                for (int bj = 0; bj < 2; ++bj)
#pragma unroll
                    for (int n = 0; n < 2; ++n) { f32x4* p = (f32x4*)(rowp + bj * HALF + n * 16); const f32x4 x = *p; *p = x * alpha + gv[bj][n] * acc[ai][bj][m][n]; } }
    }
};
template <class Epi, class Sched, bool ALIGN_EPI = false, bool SP2 = false>
__device__ __forceinline__ void gemm_phase(PG8_LAS unsigned char* lds, const Gemm g, const Sched& S, const Epi& E) {
    int tid_o = threadIdx.x; asm volatile("" : "+v"(tid_o));
    const int tid = tid_o, wid = __builtin_amdgcn_readfirstlane(tid >> 6), lane = tid & 63, wr = wid >> 2, wc = wid & 3, fr = lane & 15, fq = lane >> 4;
    const int K = g.K, nt = K / BK;
    unsigned voffA[2], voffB[2];
#pragma unroll
    for (int i = 0; i < 2; ++i) { int R, C; stage_rc(tid * 16 + i * 8192, R, C); const int Rb = Epi::PERM ? ((R & ~31) + perm32(R & 31)) : R;
        voffA[i] = (unsigned)(R * g.lda + C) * 2u; voffB[i] = (unsigned)(Rb * K + C) * 2u; }
    const size_t kstep = (size_t)(BK * 2);
    const size_t hstep = (size_t)HALF * K * 2, hstepA = (size_t)HALF * g.lda * 2;
    const size_t tstep = 2 * hstep, tstepA = 2 * hstepA;
    const unsigned ldsw = (unsigned)wid * 1024u;
    const int aoff = lds_byte(wr * 64 + fr, fq * 8), boff = lds_byte(wc * 32 + fr, fq * 8);
#define PG8_SA(b, h) (((b) * 2 + (h)) * HTB)
#define PG8_SB(b, h) ((4 + (b) * 2 + (h)) * HTB)
#define PG8_STAGE(bufoff, gbase, voff) do { _Pragma("unroll") for (int _i = 0; _i < 2; ++_i) \
        __builtin_amdgcn_global_load_lds((const unsigned*)((const char*)(gbase) + (voff)[_i]), (PG8_LAS unsigned*)(lds + (bufoff) + ldsw + _i * 8192), 16, 0, 0); } while (0)
#define PG8_LDA(dst, b, h) do { _Pragma("unroll") for (int m = 0; m < 4; ++m) _Pragma("unroll") for (int k = 0; k < 2; ++k) dst[m][k] = *(const PG8_LAS bf16x8*)(lds + PG8_SA(b, h) + aoff + m * 2048 + k * 1024); } while (0)
#define PG8_LDB(dst, b, h) do { _Pragma("unroll") for (int n = 0; n < 2; ++n) _Pragma("unroll") for (int k = 0; k < 2; ++k) dst[n][k] = *(const PG8_LAS bf16x8*)(lds + PG8_SB(b, h) + boff + n * 2048 + k * 1024); } while (0)
#define PG8_MMA(ai, bj, At, Bt) do { __builtin_amdgcn_s_setprio(1); _Pragma("unroll") for (int m = 0; m < 4; ++m) _Pragma("unroll") for (int n = 0; n < 2; ++n) _Pragma("unroll") for (int k = 0; k < 2; ++k) \
        acc[ai][bj][m][n] = __builtin_amdgcn_mfma_f32_16x16x32_bf16(Bt[n][k], At[m][k], acc[ai][bj][m][n], 0, 0, 0); __builtin_amdgcn_s_setprio(0); } while (0)
#define PG8_WAIT_V(n) asm volatile("s_waitcnt vmcnt(" #n ")" ::: "memory")
#define PG8_WAIT_L(n) asm volatile("s_waitcnt lgkmcnt(" #n ")" ::: "memory")
#define PG8_BAR __builtin_amdgcn_s_barrier()
#define PG8_SCHED __builtin_amdgcn_sched_barrier(0)
    Unit cur, nxt; int ui = 0;
    if (!S.next(0, cur)) return;
    f32x4 acc[2][2][4][2];
#pragma unroll
    for (int a = 0; a < 2; ++a)
#pragma unroll
        for (int b = 0; b < 2; ++b)
#pragma unroll
            for (int m = 0; m < 4; ++m)
#pragma unroll
                for (int n = 0; n < 2; ++n) acc[a][b][m][n] = (f32x4){0.f, 0.f, 0.f, 0.f};
    bf16x8 At[4][2], B0[2][2], B1[2][2];
    const char* cA = (const char*)g.A + (size_t)cur.pm * tstepA; const char* cB = (const char*)g.Bt + (size_t)cur.pn * tstep;
    S.a_ready(cur);
    if constexpr (SP2) {
        PG8_STAGE(PG8_SB(0, 0), cB, voffB); PG8_STAGE(PG8_SB(0, 1), cB + hstep, voffB); PG8_STAGE(PG8_SA(0, 0), cA, voffA); PG8_STAGE(PG8_SA(0, 1), cA + hstepA, voffA);
        if (wr == 1) PG8_BAR;
        PG8_WAIT_V(2); PG8_BAR;
        PG8_STAGE(PG8_SB(1, 0), cB + kstep, voffB); PG8_STAGE(PG8_SA(1, 0), cA + kstep, voffA); PG8_STAGE(PG8_SB(1, 1), cB + hstep + kstep, voffB);
        PG8_WAIT_V(6); PG8_BAR;
    } else {
        PG8_STAGE(PG8_SB(0, 0), cB, voffB); PG8_STAGE(PG8_SA(0, 0), cA, voffA); PG8_STAGE(PG8_SB(0, 1), cB + hstep, voffB); PG8_STAGE(PG8_SA(0, 1), cA + hstepA, voffA);
        if (wr == 1) PG8_BAR;
        PG8_WAIT_V(4); PG8_BAR;
        PG8_STAGE(PG8_SB(1, 0), cB + kstep, voffB); PG8_STAGE(PG8_SA(1, 0), cA + kstep, voffA); PG8_STAGE(PG8_SB(1, 1), cB + hstep + kstep, voffB);
        PG8_WAIT_V(6); PG8_BAR;
    }
    for (;;) {
        const bool has_next = S.next(ui + 1, nxt);
        const char* nA = has_next ? (const char*)g.A + (size_t)nxt.pm * tstepA : cA; const char* nB = has_next ? (const char*)g.Bt + (size_t)nxt.pn * tstep : cB;
        for (int t = 0; t < nt; t += 2) {
            const bool last = (t == nt - 2);
            const char* a1 = cA + (size_t)(t + 1) * kstep;
            const char* a2 = last ? nA : cA + (size_t)(t + 2) * kstep; const char* b2 = last ? nB : cB + (size_t)(t + 2) * kstep;
            const char* a3 = a2 + kstep; const char* b3 = b2 + kstep;
            if (last && has_next) S.a_ready(nxt);
            if constexpr (SP2) {
            PG8_LDB(B0, 0, 0); PG8_LDB(B1, 0, 1); PG8_SCHED; PG8_LDA(At, 0, 0); PG8_STAGE(PG8_SA(1, 1), a1 + hstepA, voffA);
            PG8_WAIT_V(8); PG8_WAIT_L(0); PG8_BAR; PG8_MMA(0, 0, At, B0); PG8_MMA(0, 1, At, B1); PG8_BAR; PG8_SCHED;
            PG8_LDA(At, 0, 1); PG8_STAGE(PG8_SB(0, 0), b2, voffB); PG8_STAGE(PG8_SB(0, 1), b2 + hstep, voffB); PG8_STAGE(PG8_SA(0, 0), a2, voffA);
            PG8_WAIT_V(8); PG8_WAIT_L(0); PG8_BAR; PG8_MMA(1, 0, At, B0); PG8_MMA(1, 1, At, B1); PG8_BAR; PG8_SCHED;
            PG8_LDB(B0, 1, 0); PG8_LDB(B1, 1, 1); PG8_SCHED; PG8_LDA(At, 1, 0); PG8_STAGE(PG8_SA(0, 1), a2 + hstepA, voffA);
            PG8_WAIT_V(8); PG8_WAIT_L(0); PG8_BAR; PG8_MMA(0, 0, At, B0); PG8_MMA(0, 1, At, B1); PG8_BAR; PG8_SCHED;
            PG8_LDA(At, 1, 1); PG8_STAGE(PG8_SB(1, 0), b3, voffB); PG8_STAGE(PG8_SB(1, 1), b3 + hstep, voffB); PG8_STAGE(PG8_SA(1, 0), a3, voffA);
            PG8_WAIT_V(8); PG8_WAIT_L(0); PG8_BAR; PG8_MMA(1, 0, At, B0); PG8_MMA(1, 1, At, B1); PG8_BAR; PG8_SCHED;
            } else {
            PG8_LDB(B0, 0, 0); PG8_SCHED; PG8_LDA(At, 0, 0); PG8_STAGE(PG8_SA(1, 1), a1 + hstepA, voffA);
            PG8_WAIT_L(8); PG8_BAR; PG8_WAIT_L(0); PG8_MMA(0, 0, At, B0); PG8_BAR; PG8_SCHED;
            PG8_LDB(B1, 0, 1); PG8_STAGE(PG8_SB(0, 0), b2, voffB);
            PG8_BAR; PG8_WAIT_L(0); PG8_MMA(0, 1, At, B1); PG8_BAR;
            PG8_LDA(At, 0, 1); PG8_STAGE(PG8_SA(0, 0), a2, voffA);
            PG8_BAR; PG8_WAIT_L(0); PG8_MMA(1, 0, At, B0); PG8_BAR; PG8_SCHED;
            PG8_STAGE(PG8_SB(0, 1), b2 + hstep, voffB);
            PG8_WAIT_V(6); PG8_BAR; PG8_MMA(1, 1, At, B1); PG8_BAR;
            PG8_LDB(B0, 1, 0); PG8_SCHED; PG8_LDA(At, 1, 0); PG8_STAGE(PG8_SA(0, 1), a2 + hstepA, voffA);
            PG8_WAIT_L(8); PG8_BAR; PG8_WAIT_L(0); PG8_MMA(0, 0, At, B0); PG8_BAR; PG8_SCHED;
            PG8_LDB(B1, 1, 1); PG8_STAGE(PG8_SB(1, 0), b3, voffB);
            PG8_BAR; PG8_WAIT_L(0); PG8_MMA(0, 1, At, B1); PG8_BAR;
            PG8_LDA(At, 1, 1); PG8_STAGE(PG8_SA(1, 0), a3, voffA);
            PG8_BAR; PG8_WAIT_L(0); PG8_MMA(1, 0, At, B0); PG8_BAR; PG8_SCHED;
            PG8_STAGE(PG8_SB(1, 1), b3 + hstep, voffB);
            PG8_WAIT_V(6); PG8_BAR; PG8_MMA(1, 1, At, B1); PG8_BAR;
            }
        }
        if constexpr (ALIGN_EPI) { if (wr == 0) PG8_BAR; }
        if constexpr (!Epi::AFTER_DRAIN) { E(acc, cur, wr, wc, fr, fq); S.done(cur); }
        if (!has_next) break;
#pragma unroll
        for (int a = 0; a < 2; ++a)
#pragma unroll
            for (int b = 0; b < 2; ++b)
#pragma unroll
                for (int m = 0; m < 4; ++m)
#pragma unroll
                    for (int n = 0; n < 2; ++n) acc[a][b][m][n] = (f32x4){0.f, 0.f, 0.f, 0.f};
        cur = nxt; cA = nA; cB = nB; ++ui;
        if constexpr (ALIGN_EPI) { if (wr == 1) PG8_BAR; }
    }
    PG8_WAIT_V(0);
    if constexpr (!ALIGN_EPI) { if (wr == 0) PG8_BAR; }
    PG8_BAR;
    if constexpr (Epi::AFTER_DRAIN) { E.fused(acc, cur, wr, wc, fr, fq, lds, wid, lane); S.done(cur); }
#undef PG8_SA
#undef PG8_SB
#undef PG8_STAGE
#undef PG8_LDA
#undef PG8_LDB
#undef PG8_MMA
#undef PG8_WAIT_V
#undef PG8_WAIT_L
#undef PG8_BAR
#undef PG8_SCHED
}
}

#define LAS __attribute__((address_space(3)))
typedef unsigned short bf16;
typedef short bf16x8 __attribute__((ext_vector_type(8)));
typedef short s16x4 __attribute__((ext_vector_type(4)));
typedef float f32x4 __attribute__((ext_vector_type(4)));
typedef float f32x16 __attribute__((ext_vector_type(16)));
typedef unsigned u32x4 __attribute__((ext_vector_type(4)));
typedef unsigned u32x2 __attribute__((ext_vector_type(2)));

constexpr int DM = 1024, NB = 16, SEQ = 2048, CTX = 256, DFF = 4096;
constexpr int MLAT = NB * SEQ, MCTX = NB * CTX, MTOT = MLAT + MCTX;
constexpr int NWAVES = 8, NTHR = 512;
constexpr float LN_EPS = 1e-5f, RMS_EPS = 1e-6f, LOG2E = 1.4426950408889634f, L2THETA = 13.287712379549449f;
constexpr size_t MiB = 1u << 20, MEL = 1u << 20;
constexpr size_t W_MLP = 0;
constexpr size_t W_MLA = 32 * MEL;
constexpr size_t W_MLA_STRIDE = 3 * MEL + MEL / 4;
constexpr size_t W_NA = W_MLA + 2 * W_MLA_STRIDE;
constexpr size_t W_GQA = W_NA + 4 * MEL;
constexpr size_t W_END = W_GQA + 2 * MEL + MEL / 2;
constexpr size_t WS_MOD = 90 * MiB, WS_XCTX = 92 * MiB, WS_HA = 108 * MiB, WS_SCR = 180 * MiB, WS_END = 504 * MiB;
static_assert(W_END * 2 == 90 * MiB, "weights");
constexpr int LDS_BYTES = 147456;

__device__ __forceinline__ float bf2f(unsigned short b) { return __uint_as_float((unsigned)b << 16); }
__device__ __forceinline__ unsigned pk2(float lo, float hi) { return pg8::cvt_pk_bf16(lo, hi); }
__device__ __forceinline__ float wave_sum(float v) {
#pragma unroll
    for (int o = 1; o < 64; o <<= 1) v += __shfl_xor(v, o);
    return v;
}

__device__ __forceinline__ void transpose_item(const float* W, int N, bf16* WT, int ldt, int row_off, LAS float* scr, int item, int lane) {
    const int nblk = N / 32, kb = item / nblk, nb = item % nblk, k0 = 64 * kb, n0 = 32 * nb;
#pragma unroll 8
    for (int i = 0; i < 32; ++i) { const int kk = 2 * i + (lane >> 5); scr[kk * 33 + (lane & 31)] = W[(size_t)(k0 + kk) * N + n0 + (lane & 31)]; }
    asm volatile("s_waitcnt lgkmcnt(0)" ::: "memory");
    const int c = lane & 7;
#pragma unroll
    for (int j = 0; j < 4; ++j) { const int n = (lane >> 3) + 8 * j; const LAS float* s = scr + (8 * c) * 33 + n;
        u32x4 o; o.x = pk2(s[0 * 33], s[1 * 33]); o.y = pk2(s[2 * 33], s[3 * 33]); o.z = pk2(s[4 * 33], s[5 * 33]); o.w = pk2(s[6 * 33], s[7 * 33]);
        *(u32x4*)(WT + (size_t)(row_off + n0 + n) * ldt + k0 + 8 * c) = o; }
    asm volatile("s_waitcnt lgkmcnt(0)" ::: "memory");
}

struct Args { const float* in[27]; float* out; unsigned char* ws; };

__device__ __forceinline__ void prologue(const Args& a, LAS unsigned char* lds, int tid, int lane, int wid, int G) {
    bf16* Wb = (bf16*)a.ws;
    float* mod = (float*)(a.ws + WS_MOD);
    {
        LAS float* S = (LAS float*)lds;
        LAS float* Pp = (LAS float*)(lds + 81920);
        for (int o = tid; o < 17 * 1024; o += NTHR) { const int r = o >> 10, k = o & 1023; const float v = r < 16 ? a.in[1][r * 1024 + k] : a.in[3][k]; S[k * 20 + r] = v / (1.f + __expf(-v)); }
        __syncthreads();
        for (int it = blockIdx.x; it < 4 * 96; it += G) {
            const int l = it / 96, cgp = it % 96;
            const float* w = a.in[4] + (size_t)l * 1024 * 6144 + cgp * 64 + lane;
            float acc[17];
#pragma unroll
            for (int r = 0; r < 17; ++r) acc[r] = 0.f;
            const int k0 = wid * 128;
#pragma unroll 4
            for (int k = k0; k < k0 + 128; ++k) {
                const float wv = w[(size_t)k * 6144];
                const LAS f32x4* sp = (const LAS f32x4*)(S + k * 20);
                const f32x4 s0 = sp[0], s1 = sp[1], s2 = sp[2], s3 = sp[3]; const float s4 = S[k * 20 + 16];
                acc[0] += s0[0] * wv; acc[1] += s0[1] * wv; acc[2] += s0[2] * wv; acc[3] += s0[3] * wv;
                acc[4] += s1[0] * wv; acc[5] += s1[1] * wv; acc[6] += s1[2] * wv; acc[7] += s1[3] * wv;
                acc[8] += s2[0] * wv; acc[9] += s2[1] * wv; acc[10] += s2[2] * wv; acc[11] += s2[3] * wv;
                acc[12] += s3[0] * wv; acc[13] += s3[1] * wv; acc[14] += s3[2] * wv; acc[15] += s3[3] * wv; acc[16] += s4 * wv;
            }
#pragma unroll
            for (int r = 0; r < 17; ++r) Pp[(wid * 17 + r) * 64 + lane] = acc[r];
            __syncthreads();
            for (int o = tid; o < 17 * 64; o += NTHR) { const int r = o >> 6, cj = o & 63; float s = 0.f;
#pragma unroll
                for (int kg = 0; kg < 8; ++kg) s += Pp[(kg * 17 + r) * 64 + cj];
                const int col = cgp * 64 + cj; mod[((size_t)l * 17 + r) * 6144 + col] = s + a.in[5][l * 6144 + col]; }
            __syncthreads();
        }
    }
    __syncthreads();
    LAS float* scr = (LAS float*)(lds + wid * 16384);
    const int gw = blockIdx.x * NWAVES + wid, NGW = G * NWAVES;
    for (int mi = 0; mi < 22; ++mi) {
        const float* src; int K, N, ldt, roff; bf16* dst;
        if (mi < 8) { const int l = mi >> 1; if (mi & 1) { src = a.in[11] + (size_t)l * 4 * MEL; K = 4096; N = 1024; dst = Wb + W_MLP + (size_t)l * 8 * MEL + 4 * MEL; } else { src = a.in[10] + (size_t)l * 4 * MEL; K = 1024; N = 4096; dst = Wb + W_MLP + (size_t)l * 8 * MEL; } ldt = K; roff = 0; }
        else if (mi < 18) { const int j = (mi - 8) / 5, w = (mi - 8) % 5; bf16* base = Wb + W_MLA + j * W_MLA_STRIDE;
            if (w == 0) { src = a.in[12] + (size_t)j * 1024 * 512; K = 1024; N = 512; dst = base; ldt = 1024; roff = 0; }
            else if (w == 1) { src = a.in[15] + (size_t)j * 1024 * 320; K = 1024; N = 320; dst = base; ldt = 1024; roff = 512; }
            else if (w == 2) { src = a.in[14] + (size_t)j * 512 * 1536; K = 512; N = 1536; dst = base + MEL; ldt = 512; roff = 0; }
            else if (w == 3) { src = a.in[17] + (size_t)j * 256 * 2048; K = 256; N = 2048; dst = base + MEL + 3 * MEL / 4; ldt = 256; roff = 0; }
            else { src = a.in[18] + (size_t)j * MEL; K = 1024; N = 1024; dst = base + 2 * MEL + MEL / 4; ldt = 1024; roff = 0; } }
        else if (mi == 18) { src = a.in[19]; K = 1024; N = 3072; dst = Wb + W_NA; ldt = 1024; roff = 0; }
        else if (mi == 19) { src = a.in[22]; K = 1024; N = 1024; dst = Wb + W_NA + 3 * MEL; ldt = 1024; roff = 0; }
        else if (mi == 20) { src = a.in[23]; K = 1024; N = 1536; dst = Wb + W_GQA; ldt = 1024; roff = 0; }
        else { src = a.in[26]; K = 1024; N = 1024; dst = Wb + W_GQA + MEL + MEL / 2; ldt = 1024; roff = 0; }
        const int nitems = (K / 64) * (N / 32);
        for (int it = gw; it < nitems; it += NGW) transpose_item(src, N, dst, ldt, roff, scr, it, lane);
    }
    for (int j = 0; j < 2; ++j) { u32x4* z = (u32x4*)(Wb + W_MLA + j * W_MLA_STRIDE + (size_t)832 * 1024); const int n16 = 192 * 1024 * 2 / 16;
        for (int i = blockIdx.x * NTHR + tid; i < n16; i += G * NTHR) z[i] = (u32x4){0u, 0u, 0u, 0u}; }
}

__device__ __forceinline__ void rowpass(const float* slat, const float* sctx, float* xlat, float* xctx, bool do_ln, const float* lg, const float* lb,
                                        const float* modl, int sc_off, int sh_off, bool write_ha, bf16* HA, int nrows, int lane, int wid, int G) {
    const int gw = blockIdx.x * NWAVES + wid, NGW = G * NWAVES;
    for (int row = gw; row < nrows; row += NGW) {
        const bool lat = row < MLAT;
        const float* sp = lat ? slat + (size_t)row * DM : sctx + (size_t)(row - MLAT) * DM;
        float* xp = lat ? xlat + (size_t)row * DM : xctx + (size_t)(row - MLAT) * DM;
        f32x4 v[4];
#pragma unroll
        for (int j = 0; j < 4; ++j) v[j] = *(const f32x4*)(sp + (64 * j + lane) * 4);
        if (do_ln) {
            float s = 0.f;
#pragma unroll
            for (int j = 0; j < 4; ++j) s += (v[j][0] + v[j][1]) + (v[j][2] + v[j][3]);
            const float mean = wave_sum(s) * (1.f / DM); float s2 = 0.f;
#pragma unroll
            for (int j = 0; j < 4; ++j) { v[j] = v[j] - mean; s2 += (v[j][0] * v[j][0] + v[j][1] * v[j][1]) + (v[j][2] * v[j][2] + v[j][3] * v[j][3]); }
            const float rstd = 1.f / sqrtf(wave_sum(s2) * (1.f / DM) + LN_EPS);
#pragma unroll
            for (int j = 0; j < 4; ++j) { const f32x4 g = *(const f32x4*)(lg + (64 * j + lane) * 4), b = *(const f32x4*)(lb + (64 * j + lane) * 4); v[j] = v[j] * rstd * g + b; }
        }
#pragma unroll
        for (int j = 0; j < 4; ++j) *(f32x4*)(xp + (64 * j + lane) * 4) = v[j];
        if (write_ha) {
            const float* mp = modl + (size_t)(lat ? (row >> 11) : 16) * 6144;
#pragma unroll
            for (int j = 0; j < 4; ++j) { const f32x4 sc = *(const f32x4*)(mp + sc_off + (64 * j + lane) * 4), sh = *(const f32x4*)(mp + sh_off + (64 * j + lane) * 4);
                const f32x4 h = v[j] * (sc + 1.f) + sh; u32x2 w; w.x = pk2(h[0], h[1]); w.y = pk2(h[2], h[3]);
                *(u32x2*)(HA + (size_t)row * DM + (64 * j + lane) * 4) = w; }
        }
    }
}

__device__ __forceinline__ void mla_rownorm(bf16* CQ, const float* qn, const float* kvn, int lane, int wid, int G) {
    const int gw = blockIdx.x * NWAVES + wid, NGW = G * NWAVES;
    for (int row = gw; row < MTOT; row += NGW) {
        bf16* rp = CQ + (size_t)row * 1024;
        const u32x4 qa = *(const u32x4*)(rp + lane * 8); const u32x2 ka = *(const u32x2*)(rp + 512 + lane * 4); const float pe = bf2f(rp[768 + lane]);
        float q[8], k[4];
#pragma unroll
        for (int i = 0; i < 4; ++i) { q[2 * i] = __uint_as_float(qa[i] << 16); q[2 * i + 1] = __uint_as_float(qa[i] & 0xffff0000u); }
#pragma unroll
        for (int i = 0; i < 2; ++i) { k[2 * i] = __uint_as_float(ka[i] << 16); k[2 * i + 1] = __uint_as_float(ka[i] & 0xffff0000u); }
        float sq = 0.f, sk = 0.f;
#pragma unroll
        for (int i = 0; i < 8; ++i) sq += q[i] * q[i];
#pragma unroll
        for (int i = 0; i < 4; ++i) sk += k[i] * k[i];
        const float rq = 1.f / sqrtf(wave_sum(sq) * (1.f / 512.f) + RMS_EPS), rk = 1.f / sqrtf(wave_sum(sk) * (1.f / 256.f) + RMS_EPS);
        const f32x4 g0 = *(const f32x4*)(qn + lane * 8), g1 = *(const f32x4*)(qn + lane * 8 + 4), gk = *(const f32x4*)(kvn + lane * 4);
        u32x4 qo; qo.x = pk2(q[0] * rq * g0[0], q[1] * rq * g0[1]); qo.y = pk2(q[2] * rq * g0[2], q[3] * rq * g0[3]); qo.z = pk2(q[4] * rq * g1[0], q[5] * rq * g1[1]); qo.w = pk2(q[6] * rq * g1[2], q[7] * rq * g1[3]);
        u32x2 ko; ko.x = pk2(k[0] * rk * gk[0], k[1] * rk * gk[1]); ko.y = pk2(k[2] * rk * gk[2], k[3] * rk * gk[3]);
        *(u32x4*)(rp + lane * 8) = qo; *(u32x2*)(rp + 512 + lane * 4) = ko;
        const float other = __shfl_xor(pe, 16);
        if (row < MLAT) {
            const int s = row & (SEQ - 1); const float pos = (float)((lane < 32) ? (s >> 6) : (s & 63));
            const float ang = pos * __builtin_amdgcn_exp2f(-(float)(lane & 15) * (L2THETA / 16.f));
            const float cs = __cosf(ang), sn = __sinf(ang);
            const float o = ((lane >> 4) & 1) ? (other * sn + pe * cs) : (pe * cs - other * sn);
            rp[768 + lane] = (bf16)(pk2(o, 0.f) & 0xffffu);
        }
    }
}

__device__ __forceinline__ void gqa_qkpass(bf16* QKV, const float* qn, const float* kn, int lane, int wid, int G) {
    const int gw = blockIdx.x * NWAVES + wid, NGW = G * NWAVES;
    const int d1 = lane < 32 ? lane : lane + 32, d2 = d1 + 32;
    const float gq1 = qn[d1], gq2 = qn[d2], gk1 = kn[d1], gk2 = kn[d2];
    const float fr = __builtin_amdgcn_exp2f(-(float)(lane & 31) * (L2THETA / 32.f));
    for (int it = gw; it < MTOT * 10; it += NGW) {
        const int row = it / 10, hh = it - row * 10;
        bf16* kp = QKV + (size_t)row * 1536 + hh * 128;
        const float g1 = hh < 8 ? gq1 : gk1, g2 = hh < 8 ? gq2 : gk2;
        const float x1 = bf2f(kp[d1]), x2 = bf2f(kp[d2]);
        const float rstd = 1.f / sqrtf(wave_sum(x1 * x1 + x2 * x2) * (1.f / 128.f) + RMS_EPS);
        float y1 = x1 * rstd * g1, y2 = x2 * rstd * g2;
        if (row < MLAT) {
            const int s = row & (SEQ - 1); const float pos = (float)((lane < 32) ? (s >> 6) : (s & 63));
            const float ang = pos * fr; const float cs = __cosf(ang), sn = __sinf(ang);
            const float o1 = y1 * cs - y2 * sn, o2 = y1 * sn + y2 * cs; y1 = o1; y2 = o2;
        }
        kp[d1] = (bf16)(pk2(y1, 0.f) & 0xffffu); kp[d2] = (bf16)(pk2(y2, 0.f) & 0xffffu);
    }
}
__device__ __forceinline__ void mla_qrope(bf16* Qb, int lane, int wid, int G) {
    const int gw = blockIdx.x * NWAVES + wid, NGW = G * NWAVES;
    const int hd = lane >> 3, half = (lane >> 2) & 1, i0 = 4 * (lane & 3);
    float fr[4];
#pragma unroll
    for (int i = 0; i < 4; ++i) fr[i] = __builtin_amdgcn_exp2f(-(float)(i0 + i) * (L2THETA / 16.f));
    for (int row = gw; row < MLAT; row += NGW) {
        bf16* p = Qb + (size_t)row * 1536 + hd * 192 + 128 + 32 * half + i0;
        const u32x2 a = *(const u32x2*)p, b = *(const u32x2*)(p + 16);
        const int s = row & (SEQ - 1); const float pos = (float)(half == 0 ? (s >> 6) : (s & 63));
        float x1[4], x2[4], o1[4], o2[4];
        x1[0] = __uint_as_float(a.x << 16); x1[1] = __uint_as_float(a.x & 0xffff0000u); x1[2] = __uint_as_float(a.y << 16); x1[3] = __uint_as_float(a.y & 0xffff0000u);
        x2[0] = __uint_as_float(b.x << 16); x2[1] = __uint_as_float(b.x & 0xffff0000u); x2[2] = __uint_as_float(b.y << 16); x2[3] = __uint_as_float(b.y & 0xffff0000u);
#pragma unroll
        for (int i = 0; i < 4; ++i) { const float ang = pos * fr[i]; const float cs = __cosf(ang), sn = __sinf(ang); o1[i] = x1[i] * cs - x2[i] * sn; o2[i] = x1[i] * sn + x2[i] * cs; }
        u32x2 wa, wb; wa.x = pk2(o1[0], o1[1]); wa.y = pk2(o1[2], o1[3]); wb.x = pk2(o2[0], o2[1]); wb.y = pk2(o2[2], o2[3]);
        *(u32x2*)p = wa; *(u32x2*)(p + 16) = wb;
    }
}

struct AttnP { const bf16* Q; int ldq; const bf16* K; int ldk; const bf16* K2; int ldk2; const bf16* V; int ldv; bf16* O; const float* gq; const float* rpb; };
typedef LAS const char* lds_cptr;
typedef short v4i16_t __attribute__((ext_vector_type(4)));
__device__ __forceinline__ s16x4 vtr(lds_cptr p) { return __builtin_bit_cast(s16x4, __builtin_amdgcn_ds_read_tr16_b64_v4i16((LAS v4i16_t*)p)); }
__device__ __forceinline__ int crow(int r, int hi) { return (r & 3) + 8 * (r >> 2) + 4 * hi; }

template <int MODE>
__device__ __forceinline__ void attn_unit(const AttnP& P, int b, int h, int qb, bool isctx, LAS unsigned char* lds, int tid, int lane, int wid) {
    constexpr int DK = MODE == 0 ? 192 : (MODE == 1 ? 64 : 128), DV = MODE == 1 ? 64 : 128;
    constexpr int KSTR = DK * 2 + 16, VSTR = DV * 2 + 64, VOFF = 64 * KSTR, TILEB = 64 * (KSTR + VSTR);
    constexpr int NKD = DK / 16, NDB = DV / 32;
    constexpr int KC = MODE == 1 ? 1 : 2, VC = MODE == 1 ? 1 : 2, CSH = MODE == 1 ? 3 : 4, CMASK = MODE == 1 ? 7 : 15;
    constexpr float SC = (MODE == 0 ? 0.07216878364870322f : (MODE == 1 ? 0.125f : 0.08838834764831845f)) * LOG2E;
    const int r32 = lane & 31, hi = lane >> 5;
    const int qloc = wid * 32 + r32;
    const size_t qg = isctx ? (size_t)(MLAT + b * CTX + qloc) : (size_t)b * SEQ + qb * 256 + qloc;
    const int spos = qb * 256 + qloc;
    const int qoff = MODE == 0 ? h * 192 : (MODE == 1 ? h * 64 : h * 128);
    const int koff = MODE == 0 ? h * 256 : (MODE == 1 ? 1024 + h * 64 : 1024 + (h >> 2) * 128);
    const int voff = MODE == 0 ? h * 256 + 128 : (MODE == 1 ? 2048 + h * 64 : 1280 + (h >> 2) * 128);
    const int ooff = MODE == 1 ? h * 64 : h * 128;
    bf16x8 qf[NKD];
    { const bf16* qp = P.Q + qg * P.ldq + qoff + hi * 8;
#pragma unroll
      for (int d0 = 0; d0 < NKD; ++d0) qf[d0] = *(const bf16x8*)(qp + d0 * 16); }
    int kr_lo = 0, NT = isctx ? 4 : 36, rs_w = 0, rq = 0;
    if constexpr (MODE == 1) {
        if (!isctx) { const int R0 = qb * 4; const int lo = min(max(R0 - 4, 0), 24), hiw = min(max(R0 + 3 - 4, 0), 24) + 7; kr_lo = lo; NT = 4 + (hiw - lo + 1);
            rq = R0 + (wid >> 1); rs_w = min(max(rq - 4, 0), 24); }
        LAS float* rl = (LAS float*)(lds + 2 * TILEB);
        if (tid < 465) rl[tid] = P.rpb[h * 465 + tid] * LOG2E;
    }
    const size_t ctx_base = (size_t)MLAT + (size_t)b * CTX, lat_base = (size_t)b * SEQ;
    u32x4 kreg[KC], vreg[VC], k2reg;
#define ATT_TROW(t) ((t) < 4 ? ctx_base + (size_t)(t) * 64 : lat_base + (size_t)(kr_lo + (t) - 4) * 64)
#define ATT_LOAD(t) do { const size_t trow_ = ATT_TROW(t); \
        _Pragma("unroll") for (int i_ = 0; i_ < KC; ++i_) { const int c_ = tid + NTHR * i_; kreg[i_] = *(const u32x4*)(P.K + (trow_ + (c_ >> CSH)) * P.ldk + koff + (c_ & CMASK) * 8); } \
        if constexpr (MODE == 0) k2reg = *(const u32x4*)(P.K2 + (trow_ + (tid >> 3)) * P.ldk2 + (tid & 7) * 8); \
        _Pragma("unroll") for (int i_ = 0; i_ < VC; ++i_) { const int c_ = tid + NTHR * i_; vreg[i_] = *(const u32x4*)(P.V + (trow_ + (c_ >> CSH)) * P.ldv + voff + (c_ & CMASK) * 8); } } while (0)
    ATT_LOAD(0);
    float m_run = -1e30f, l_run = 0.f;
    f32x16 o[NDB];
#pragma unroll
    for (int d = 0; d < NDB; ++d) o[d] = f32x16{};
    const lds_cptr lds3 = (lds_cptr)lds;
    const int kbase_off = r32 * KSTR + hi * 16;
    const int vbase_off = VOFF + (4 * hi + ((lane & 15) >> 2)) * VSTR + (((lane >> 4) & 1) * 16 + (lane & 3) * 4) * 2;
    for (int t = 0; t < NT; ++t) {
        LAS unsigned char* buf = lds + (t & 1) * TILEB;
#pragma unroll
        for (int i = 0; i < KC; ++i) { const int c = tid + NTHR * i; *(LAS u32x4*)(buf + (c >> CSH) * KSTR + (c & CMASK) * 16) = kreg[i]; }
        if constexpr (MODE == 0) *(LAS u32x4*)(buf + (tid >> 3) * KSTR + 256 + (tid & 7) * 16) = k2reg;
#pragma unroll
        for (int i = 0; i < VC; ++i) { const int c = tid + NTHR * i; *(LAS u32x4*)(buf + VOFF + (c >> CSH) * VSTR + (c & CMASK) * 16) = vreg[i]; }
        __syncthreads();
        if (t + 1 < NT) ATT_LOAD(t + 1);
        bool active = true; int kr = 0;
        if constexpr (MODE == 1) { if (t >= 4) { kr = kr_lo + t - 4; active = (kr >= rs_w) && (kr < rs_w + 8); } }
        if (active) {
            const lds_cptr kb3 = lds3 + (t & 1) * TILEB + kbase_off;
            f32x16 s0 = f32x16{}, s1 = f32x16{};
#pragma unroll
            for (int d0 = 0; d0 < NKD; ++d0) {
                const bf16x8 k0 = *(const LAS bf16x8*)(kb3 + d0 * 32), k1 = *(const LAS bf16x8*)(kb3 + 32 * KSTR + d0 * 32);
                s0 = __builtin_amdgcn_mfma_f32_32x32x16_bf16(k0, qf[d0], s0, 0, 0, 0);
                s1 = __builtin_amdgcn_mfma_f32_32x32x16_bf16(k1, qf[d0], s1, 0, 0, 0);
                if ((d0 & 3) == 3) __builtin_amdgcn_sched_barrier(0);
            }
            float mx;
            if constexpr (MODE == 1) {
                if (t >= 4) {
                    const int c = (wid & 1) * 32 + r32, cst = min(max(c - 8, 0), 48);
                    const LAS float* rl = (const LAS float*)(lds + 2 * TILEB) + (kr - rq + 7) * 31 + 15 - c;
#pragma unroll
                    for (int r = 0; r < 16; ++r) { const int kc0 = crow(r, hi), kc1 = kc0 + 32;
                        const bool v0 = (kc0 >= cst) && (kc0 < cst + 16), v1 = (kc1 >= cst) && (kc1 < cst + 16);
                        const float b0 = rl[v0 ? kc0 : c], b1 = rl[v1 ? kc1 : c];
                        s0[r] = v0 ? s0[r] * SC + b0 : -1e30f; s1[r] = v1 ? s1[r] * SC + b1 : -1e30f; }
                } else {
#pragma unroll
                    for (int r = 0; r < 16; ++r) { s0[r] *= SC; s1[r] *= SC; }
                }
            }
            mx = fmaxf(s0[0], s1[0]);
#pragma unroll
            for (int r = 1; r < 16; ++r) mx = fmaxf(mx, fmaxf(s0[r], s1[r]));
            mx = fmaxf(mx, __shfl_xor(mx, 32));
            if constexpr (MODE != 1) mx *= SC;
            const float m_new = fmaxf(m_run, mx);
            const float alpha = __builtin_amdgcn_exp2f(m_run - m_new); m_run = m_new;
            float ps = 0.f;
#pragma unroll
            for (int r = 0; r < 16; ++r) {
                if constexpr (MODE == 1) { s0[r] = __builtin_amdgcn_exp2f(s0[r] - m_new); s1[r] = __builtin_amdgcn_exp2f(s1[r] - m_new); }
                else { s0[r] = __builtin_amdgcn_exp2f(s0[r] * SC - m_new); s1[r] = __builtin_amdgcn_exp2f(s1[r] * SC - m_new); }
                ps += s0[r] + s1[r];
            }
            l_run = l_run * alpha + ps;
#pragma unroll
            for (int d = 0; d < NDB; ++d) o[d] = o[d] * alpha;
            u32x4 pw[2][2];
#pragma unroll
            for (int ks = 0; ks < 2; ++ks) {
                pw[0][ks] = (u32x4){pk2(s0[8 * ks], s0[8 * ks + 1]), pk2(s0[8 * ks + 2], s0[8 * ks + 3]), pk2(s0[8 * ks + 4], s0[8 * ks + 5]), pk2(s0[8 * ks + 6], s0[8 * ks + 7])};
                pw[1][ks] = (u32x4){pk2(s1[8 * ks], s1[8 * ks + 1]), pk2(s1[8 * ks + 2], s1[8 * ks + 3]), pk2(s1[8 * ks + 4], s1[8 * ks + 5]), pk2(s1[8 * ks + 6], s1[8 * ks + 7])};
            }
            const lds_cptr vb3 = lds3 + (t & 1) * TILEB + vbase_off;
#pragma unroll
            for (int d = 0; d < NDB; ++d)
#pragma unroll
                for (int kb = 0; kb < 2; ++kb)
#pragma unroll
                    for (int ks = 0; ks < 2; ++ks) {
                        const s16x4 lo = vtr(vb3 + (32 * kb + 16 * ks) * VSTR + d * 64), hh = vtr(vb3 + (32 * kb + 16 * ks + 8) * VSTR + d * 64);
                        const bf16x8 vf = (bf16x8){lo[0], lo[1], lo[2], lo[3], hh[0], hh[1], hh[2], hh[3]};
                        o[d] = __builtin_amdgcn_mfma_f32_32x32x16_bf16(vf, __builtin_bit_cast(bf16x8, pw[kb][ks]), o[d], 0, 0, 0);
                        if (kb == 1 && ks == 1) __builtin_amdgcn_sched_barrier(0);
                    }
        }
    }
#undef ATT_LOAD
#undef ATT_TROW
    l_run += __shfl_xor(l_run, 32);
    const float inv = 1.f / l_run;
    bf16* op = P.O + qg * DM + ooff + 4 * hi;
#pragma unroll
    for (int d = 0; d < NDB; ++d)
#pragma unroll
        for (int g = 0; g < 4; ++g) { u32x2 w; w.x = pk2(o[d][4 * g] * inv, o[d][4 * g + 1] * inv); w.y = pk2(o[d][4 * g + 2] * inv, o[d][4 * g + 3] * inv);
            *(u32x2*)(op + d * 32 + g * 8) = w; }
    __syncthreads();
}

template <int MODE>
__device__ __forceinline__ void attn_phase(const AttnP& P, bool need_ctx, LAS unsigned char* lds, int tid, int lane, int wid, int G) {
    constexpr int NH = MODE == 1 ? 16 : 8;
    const int bx = blockIdx.x; const int vcu = (G % 8 == 0) ? (bx % 8) * (G / 8) + bx / 8 : bx;
    const int nlat = NB * NH * 8, nctx = need_ctx ? NB * NH : 0;
    for (int u = vcu; u < nlat + nctx; u += G) {
        if (u < nlat) { const int qb = u & 7, bh = u >> 3; attn_unit<MODE>(P, bh / NH, bh % NH, qb, false, lds, tid, lane, wid); }
        else { const int bh = u - nlat; attn_unit<MODE>(P, bh / NH, bh % NH, 0, true, lds, tid, lane, wid); }
    }
}

__global__ void __launch_bounds__(NTHR, 2) mega_fwd(Args a) {
    extern __shared__ __attribute__((aligned(16))) unsigned char lds_raw[];
    LAS unsigned char* lds = (LAS unsigned char*)lds_raw;
    cg::grid_group grid = cg::this_grid();
    const int tid = threadIdx.x, lane = tid & 63, wid = __builtin_amdgcn_readfirstlane(tid >> 6), G = gridDim.x;
    unsigned char* ws = a.ws;
    bf16* Wb = (bf16*)ws; float* mod = (float*)(ws + WS_MOD); float* xctx = (float*)(ws + WS_XCTX); float* xlat = a.out;
    bf16* HA = (bf16*)(ws + WS_HA); bf16* SCR = (bf16*)(ws + WS_SCR);
    const float alpha = 1.681792830507429f;

#ifndef T_NOPRO
    prologue(a, lds, tid, lane, wid, G);
#endif
    grid.sync();
    rowpass(a.in[0], a.in[2], xlat, xctx, false, nullptr, nullptr, mod, 1024, 0, true, HA, MTOT, lane, wid, G);
    grid.sync();

    for (int layer = 0; layer < 4; ++layer) {
        const int kind = layer % 3, j = layer / 3;
        const bool need_ctx = layer < 3;
        const int Mx = need_ctx ? MTOT : MLAT;
        const float* modl = mod + (size_t)layer * 17 * 6144;
        const int head = kind == 0 ? 6 : (kind == 1 ? 2 : 3);
        for (int op = 0; op < head + 5; ++op) {
            int tid = threadIdx.x; asm volatile("" : "+v"(tid)); const int lane = tid & 63;
            int type = 0; bool sync_after = true;
            pg8::Gemm g{nullptr, 0, nullptr, 0, 0, 0}; pg8::EpiBf16 eb{nullptr, 0, nullptr, 0}; int goff = 0; int lnsub = 0;
            if (op < head) {
                if (kind == 0) {
                    bf16* base = Wb + W_MLA + j * W_MLA_STRIDE; bf16* CQ = SCR; bf16* Qb = SCR + (size_t)MTOT * 1024; bf16* KV = Qb + (size_t)MTOT * 1536;
                    if (op == 0) { g = pg8::Gemm{HA, 1024, base, MTOT, 1024, 1024}; eb = pg8::EpiBf16{CQ, 1024, nullptr, 0}; }
                    else if (op == 1) type = 3;
                    else if (op == 2) { g = pg8::Gemm{CQ, 1024, base + MEL, Mx, 1536, 512}; eb = pg8::EpiBf16{Qb, 1536, nullptr, 0}; sync_after = false; }
                    else if (op == 3) { g = pg8::Gemm{CQ + 512, 1024, base + MEL + 3 * MEL / 4, MTOT, 2048, 256}; eb = pg8::EpiBf16{KV, 2048, nullptr, 0}; }
                    else if (op == 4) type = 6;
                    else type = 2;
                } else if (kind == 1) {
                    if (op == 0) { g = pg8::Gemm{HA, 1024, Wb + W_NA, MTOT, 3072, 1024}; eb = pg8::EpiBf16{SCR, 3072, a.in[20], 0}; }
                    else type = 2;
                } else {
                    if (op == 0) { g = pg8::Gemm{HA, 1024, Wb + W_GQA, MTOT, 1536, 1024}; eb = pg8::EpiBf16{SCR, 1536, nullptr, 0}; }
                    else if (op == 1) type = 4;
                    else type = 2;
                }
            } else {
                const int to = op - head;
                if (to == 0) { type = 1; const bf16* wo = kind == 0 ? Wb + W_MLA + j * W_MLA_STRIDE + 2 * MEL + MEL / 4 : (kind == 1 ? Wb + W_NA + 3 * MEL : Wb + W_GQA + MEL + MEL / 2);
                    g = pg8::Gemm{HA, 1024, wo, Mx, 1024, 1024}; goff = 2048; }
                else if (to == 1) { type = 5; lnsub = 0; }
                else if (to == 2) { g = pg8::Gemm{HA, 1024, Wb + W_MLP + (size_t)layer * 8 * MEL, Mx, 4096, 1024}; eb = pg8::EpiBf16{SCR, 4096, nullptr, 1}; }
                else if (to == 3) { type = 1; g = pg8::Gemm{SCR, 4096, Wb + W_MLP + (size_t)layer * 8 * MEL + 4 * MEL, Mx, 1024, 4096}; goff = 5120; }
                else { type = 5; lnsub = 1; }
            }
#ifndef T_NOGEMM
            if (type == 0) {
                pg8::StaticOrder S; S.init(g.M, g.N, G, (int)blockIdx.x);
                pg8::gemm_phase<pg8::EpiBf16, pg8::StaticOrder, true, true>(lds, g, S, eb);
            } else if (type == 1) {
                pg8::StaticOrder S; S.init(g.M, g.N, G, (int)blockIdx.x);
                pg8::EpiResid er{xlat, xctx, modl + goff, alpha};
                pg8::gemm_phase<pg8::EpiResid, pg8::StaticOrder, true, true>(lds, g, S, er);
            } else
#endif
            if (type == 2) {
                if (kind == 0) { bf16* CQ = SCR; bf16* Qb = SCR + (size_t)MTOT * 1024; bf16* KV = Qb + (size_t)MTOT * 1536;
                    AttnP P{Qb, 1536, KV, 2048, CQ + 768, 1024, KV, 2048, HA, nullptr, nullptr};
#ifndef T_NOA0
attn_phase<0>(P, need_ctx, lds, tid, lane, wid, G);
#endif
 }
                else if (kind == 1) { AttnP P{SCR, 3072, SCR, 3072, nullptr, 0, SCR, 3072, HA, nullptr, a.in[21]};
#ifndef T_NOA1
attn_phase<1>(P, need_ctx, lds, tid, lane, wid, G);
#endif
 }
                else { AttnP P{SCR, 1536, SCR, 1536, nullptr, 0, SCR, 1536, HA, a.in[24], nullptr};
#ifndef T_NOA2
attn_phase<2>(P, need_ctx, lds, tid, lane, wid, G);
#endif
 }
            } else if (type == 3) {
                mla_rownorm(SCR, a.in[13] + j * 512, a.in[16] + j * 256, lane, wid, G);
            } else if (type == 4) {
                gqa_qkpass(SCR, a.in[24], a.in[25], lane, wid, G);
            } else if (type == 6) {
                mla_qrope(SCR + (size_t)MTOT * 1024, lane, wid, G);
            } else {
                if (lnsub == 0) rowpass(xlat, xctx, xlat, xctx, true, a.in[6] + layer * DM, a.in[7] + layer * DM, modl, 4096, 3072, true, HA, Mx, lane, wid, G);
                else { const bool last = layer == 3; rowpass(xlat, xctx, xlat, xctx, true, a.in[8] + layer * DM, a.in[9] + layer * DM, modl + 17 * 6144, 1024, 0, !last, HA, Mx, lane, wid, G); }
            }
            if (sync_after && !(layer == 3 && op == head + 4)) grid.sync();
        }
    }
}

extern "C" void kernel_launch(void* const* d_in, const int* in_sizes, int n_in, void* d_out, int out_size, void* d_ws, size_t ws_size, hipStream_t stream) {
    static int grid_blocks = 0;
    if (grid_blocks == 0) {
        if (n_in != 27 || out_size != MLAT * DM || ws_size < WS_END) { fprintf(stderr, "kernel_launch: unexpected shapes (n_in %d, out %d, ws %zu)\n", n_in, out_size, ws_size); grid_blocks = -1; return; }
        int dev = 0, cus = 0, per_cu = 0;
        hipGetDevice(&dev);
        hipDeviceGetAttribute(&cus, hipDeviceAttributeMultiprocessorCount, dev);
        hipFuncSetAttribute((const void*)mega_fwd, hipFuncAttributeMaxDynamicSharedMemorySize, LDS_BYTES);
        hipOccupancyMaxActiveBlocksPerMultiprocessor(&per_cu, (const void*)mega_fwd, NTHR, LDS_BYTES);
        if (per_cu < 1) per_cu = 1;
        grid_blocks = cus * per_cu;
    }
    if (grid_blocks < 0) return;
    Args a{};
    for (int i = 0; i < 27; ++i) a.in[i] = (const float*)d_in[i];
    a.out = (float*)d_out; a.ws = (unsigned char*)d_ws;
    void* args[] = {&a};
    hipError_t e = hipLaunchCooperativeKernel((const void*)mega_fwd, dim3(grid_blocks), dim3(NTHR), args, LDS_BYTES, stream);
    if (e != hipSuccess) fprintf(stderr, "cooperative launch failed: %s (grid %d)\n", hipGetErrorString(e), grid_blocks);
}
```

```cpp
#include <hip/hip_runtime.h>
#include <hip/hip_cooperative_groups.h>
#include <cstdio>
#include <cstdint>
namespace cg = cooperative_groups;
namespace pg8 {
#define PG8_LAS __attribute__((address_space(3)))
typedef unsigned short bf16_t;
typedef short bf16x8 __attribute__((ext_vector_type(8)));
typedef float f32x4 __attribute__((ext_vector_type(4)));
typedef unsigned u32x4 __attribute__((ext_vector_type(4)));
constexpr int BM = 256, BK = 64, HALF = 128, HTB = HALF * BK * 2  , STAGE_BYTES = 8 * HTB, NXCD = 8, WGM = 8;

__host__ __device__ __forceinline__ int lds_byte(int r, int c) { const int st = (r >> 4) * 2 + (c >> 5), rr = r & 15, cc = c & 31, ob = rr * 64 + cc * 2; return st * 1024 + (ob ^ (((ob >> 9) & 1) << 5)); }
__host__ __device__ __forceinline__ void stage_rc(int b, int& R, int& C) { const int st = b / 1024, sb = b % 1024, swz = sb ^ (((sb >> 9) & 1) << 5); R = (st >> 1) * 16 + swz / 64; C = (st & 1) * 32 + (swz % 64) / 2; }
__host__ __device__ __forceinline__ int perm32(int rho) { const int n = rho >> 4, i = rho & 15; return 8 * (i >> 2) + 4 * n + (i & 3); }

struct Unit { int pm, pn; };
struct Gemm { const bf16_t* A; int lda; const bf16_t* Bt; int M, N, K; };

struct StaticOrder {
    int nM, nN, nwg, G, c;
    __host__ __device__ void init(int M, int N, int G_, int c_) { nM = M / BM; nN = N / BM; nwg = nM * nN; G = G_; c = c_; }
    __host__ __device__ bool next(int i, Unit& u) const {
        const long L = (long)i * G + c; if (L >= nwg) return false;
        int wgid = (int)L; { const int q = nwg / NXCD, r = nwg % NXCD, xcd = wgid % NXCD, off = wgid / NXCD; wgid = (xcd < r ? xcd * (q + 1) : r * (q + 1) + (xcd - r) * q) + off; }
        const int nig = WGM * nN, gid = wgid / nig, fm = gid * WGM, gsz = (nM - fm) < WGM ? (nM - fm) : WGM;
        u.pm = fm + ((wgid % nig) % gsz); u.pn = (wgid % nig) / gsz; return true;
    }
    __device__ __forceinline__ void a_ready(const Unit&) const {}
    __device__ __forceinline__ void done(const Unit&) const {}
};

typedef float f32x2 __attribute__((ext_vector_type(2)));
typedef __bf16 bf16x2_t __attribute__((ext_vector_type(2)));
__device__ __forceinline__ unsigned cvt_pk_bf16(float lo, float hi) { f32x2 v = {lo, hi}; bf16x2_t b = __builtin_convertvector(v, bf16x2_t); return __builtin_bit_cast(unsigned, b); }

struct EpiBf16 {
    static constexpr bool PERM = true, AFTER_DRAIN = false;
    bf16_t* O; int ldc; const float* bias; int act;
    __device__ __forceinline__ void operator()(const f32x4 (&acc)[2][2][4][2], const Unit& u, int wr, int wc, int fr, int fq) const {
        const int row0 = u.pm * BM + wr * 64 + fr; const int col0 = u.pn * BM + wc * 32 + 8 * fq;
        f32x4 bv[2][2];
#pragma unroll
        for (int bj = 0; bj < 2; ++bj)
#pragma unroll
            for (int n = 0; n < 2; ++n) bv[bj][n] = bias ? *(const f32x4*)(bias + col0 + bj * HALF + 4 * n) : (f32x4){0.f, 0.f, 0.f, 0.f};
#pragma unroll
        for (int ai = 0; ai < 2; ++ai)
#pragma unroll
            for (int m = 0; m < 4; ++m) { bf16_t* rowp = O + (size_t)(row0 + ai * HALF + m * 16) * ldc + col0;
#pragma unroll
                for (int bj = 0; bj < 2; ++bj) { f32x4 v0 = acc[ai][bj][m][0] + bv[bj][0], v1 = acc[ai][bj][m][1] + bv[bj][1];
                    if (act) {
#pragma unroll
                        for (int j = 0; j < 4; ++j) { float a = v0[j] > 0.f ? v0[j] : 0.f, b = v1[j] > 0.f ? v1[j] : 0.f; v0[j] = a * a; v1[j] = b * b; } }
                    u32x4 w; w.x = cvt_pk_bf16(v0[0], v0[1]); w.y = cvt_pk_bf16(v0[2], v0[3]); w.z = cvt_pk_bf16(v1[0], v1[1]); w.w = cvt_pk_bf16(v1[2], v1[3]);
                    *(u32x4*)(rowp + bj * HALF) = w; } }
    }
};
struct EpiResid {
    static constexpr bool PERM = false, AFTER_DRAIN = false;
    const float* slat; const float* sctx; float* xlat; float* xctx; const float* gate; float alpha;
    __device__ __forceinline__ void operator()(const f32x4 (&acc)[2][2][4][2], const Unit& u, int wr, int wc, int fr, int fq) const {
        const int col0 = u.pn * BM + wc * 32 + 4 * fq;
        const int midx = u.pm < 128 ? (u.pm >> 3) : 16;
        float* xb = u.pm < 128 ? xlat + (size_t)u.pm * BM * 1024 : xctx + (size_t)(u.pm - 128) * BM * 1024;
        const float* sb = u.pm < 128 ? slat + (size_t)u.pm * BM * 1024 : sctx + (size_t)(u.pm - 128) * BM * 1024;
        const float* gp = gate + (size_t)midx * 6144 + col0;
        f32x4 gv[2][2];
#pragma unroll
        for (int bj = 0; bj < 2; ++bj)
#pragma unroll
            for (int n = 0; n < 2; ++n) gv[bj][n] = *(const f32x4*)(gp + bj * HALF + n * 16);
#pragma unroll
        for (int ai = 0; ai < 2; ++ai)
#pragma unroll
            for (int m = 0; m < 4; ++m) { const size_t ro = (size_t)(wr * 64 + fr + ai * HALF + m * 16) * 1024 + col0; float* rowp = xb + ro; const float* srow = sb + ro;
#pragma unroll
                for (int bj = 0; bj < 2; ++bj)
#pragma unroll
                    for (int n = 0; n < 2; ++n) { f32x4* p = (f32x4*)(rowp + bj * HALF + n * 16); const f32x4 x = *(const f32x4*)(srow + bj * HALF + n * 16); *p = x * alpha + gv[bj][n] * acc[ai][bj][m][n]; } }
    }
};
template <class Epi, class Sched, bool ALIGN_EPI = false, bool SP2 = false>
__device__ __forceinline__ void gemm_phase(PG8_LAS unsigned char* lds, const Gemm g, const Sched& S, const Epi& E) {
    int tid_o = threadIdx.x; asm volatile("" : "+v"(tid_o));
    const int tid = tid_o, wid = __builtin_amdgcn_readfirstlane(tid >> 6), lane = tid & 63, wr = wid >> 2, wc = wid & 3, fr = lane & 15, fq = lane >> 4;
    const int K = g.K, nt = K / BK;
    unsigned voffA[2], voffB[2];
#pragma unroll
    for (int i = 0; i < 2; ++i) { int R, C; stage_rc(tid * 16 + i * 8192, R, C); const int Rb = Epi::PERM ? ((R & ~31) + perm32(R & 31)) : R;
        voffA[i] = (unsigned)(R * g.lda + C) * 2u; voffB[i] = (unsigned)(Rb * K + C) * 2u; }
    const size_t kstep = (size_t)(BK * 2);
    const size_t hstep = (size_t)HALF * K * 2, hstepA = (size_t)HALF * g.lda * 2;
    const size_t tstep = 2 * hstep, tstepA = 2 * hstepA;
    const unsigned ldsw = (unsigned)wid * 1024u;
    const int aoff = lds_byte(wr * 64 + fr, fq * 8), boff = lds_byte(wc * 32 + fr, fq * 8);
#define PG8_SA(b, h) (((b) * 2 + (h)) * HTB)
#define PG8_SB(b, h) ((4 + (b) * 2 + (h)) * HTB)
#define PG8_STAGE(bufoff, gbase, voff) do { _Pragma("unroll") for (int _i = 0; _i < 2; ++_i) \
        __builtin_amdgcn_global_load_lds((const unsigned*)((const char*)(gbase) + (voff)[_i]), (PG8_LAS unsigned*)(lds + (bufoff) + ldsw + _i * 8192), 16, 0, 0); } while (0)
#define PG8_LDA(dst, b, h) do { _Pragma("unroll") for (int m = 0; m < 4; ++m) _Pragma("unroll") for (int k = 0; k < 2; ++k) dst[m][k] = *(const PG8_LAS bf16x8*)(lds + PG8_SA(b, h) + aoff + m * 2048 + k * 1024); } while (0)
#define PG8_LDB(dst, b, h) do { _Pragma("unroll") for (int n = 0; n < 2; ++n) _Pragma("unroll") for (int k = 0; k < 2; ++k) dst[n][k] = *(const PG8_LAS bf16x8*)(lds + PG8_SB(b, h) + boff + n * 2048 + k * 1024); } while (0)
#define PG8_MMA(ai, bj, At, Bt) do { __builtin_amdgcn_s_setprio(1); _Pragma("unroll") for (int m = 0; m < 4; ++m) _Pragma("unroll") for (int n = 0; n < 2; ++n) _Pragma("unroll") for (int k = 0; k < 2; ++k) \
        acc[ai][bj][m][n] = __builtin_amdgcn_mfma_f32_16x16x32_bf16(Bt[n][k], At[m][k], acc[ai][bj][m][n], 0, 0, 0); __builtin_amdgcn_s_setprio(0); } while (0)
#define PG8_WAIT_V(n) asm volatile("s_waitcnt vmcnt(" #n ")" ::: "memory")
#define PG8_WAIT_L(n) asm volatile("s_waitcnt lgkmcnt(" #n ")" ::: "memory")
#define PG8_BAR __builtin_amdgcn_s_barrier()
#define PG8_SCHED __builtin_amdgcn_sched_barrier(0)
    Unit cur, nxt; int ui = 0;
    if (!S.next(0, cur)) return;
    f32x4 acc[2][2][4][2];
#pragma unroll
    for (int a = 0; a < 2; ++a)
#pragma unroll
        for (int b = 0; b < 2; ++b)
#pragma unroll
            for (int m = 0; m < 4; ++m)
#pragma unroll
                for (int n = 0; n < 2; ++n) acc[a][b][m][n] = (f32x4){0.f, 0.f, 0.f, 0.f};
    bf16x8 At[4][2], B0[2][2], B1[2][2];
    const char* cA = (const char*)g.A + (size_t)cur.pm * tstepA; const char* cB = (const char*)g.Bt + (size_t)cur.pn * tstep;
    S.a_ready(cur);
    if constexpr (SP2) {
        PG8_STAGE(PG8_SB(0, 0), cB, voffB); PG8_STAGE(PG8_SB(0, 1), cB + hstep, voffB); PG8_STAGE(PG8_SA(0, 0), cA, voffA); PG8_STAGE(PG8_SA(0, 1), cA + hstepA, voffA);
        if (wr == 1) PG8_BAR;
        PG8_WAIT_V(2); PG8_BAR;
        PG8_STAGE(PG8_SB(1, 0), cB + kstep, voffB); PG8_STAGE(PG8_SA(1, 0), cA + kstep, voffA); PG8_STAGE(PG8_SB(1, 1), cB + hstep + kstep, voffB);
        PG8_WAIT_V(6); PG8_BAR;
    } else {
        PG8_STAGE(PG8_SB(0, 0), cB, voffB); PG8_STAGE(PG8_SA(0, 0), cA, voffA); PG8_STAGE(PG8_SB(0, 1), cB + hstep, voffB); PG8_STAGE(PG8_SA(0, 1), cA + hstepA, voffA);
        if (wr == 1) PG8_BAR;
        PG8_WAIT_V(4); PG8_BAR;
        PG8_STAGE(PG8_SB(1, 0), cB + kstep, voffB); PG8_STAGE(PG8_SA(1, 0), cA + kstep, voffA); PG8_STAGE(PG8_SB(1, 1), cB + hstep + kstep, voffB);
        PG8_WAIT_V(6); PG8_BAR;
    }
    for (;;) {
        const bool has_next = S.next(ui + 1, nxt);
        const char* nA = has_next ? (const char*)g.A + (size_t)nxt.pm * tstepA : cA; const char* nB = has_next ? (const char*)g.Bt + (size_t)nxt.pn * tstep : cB;
        for (int t = 0; t < nt; t += 2) {
            const bool last = (t == nt - 2);
            const char* a1 = cA + (size_t)(t + 1) * kstep;
            const char* a2 = last ? nA : cA + (size_t)(t + 2) * kstep; const char* b2 = last ? nB : cB + (size_t)(t + 2) * kstep;
            const char* a3 = a2 + kstep; const char* b3 = b2 + kstep;
            if (last && has_next) S.a_ready(nxt);
            if constexpr (SP2) {
            PG8_LDB(B0, 0, 0); PG8_LDB(B1, 0, 1); PG8_SCHED; PG8_LDA(At, 0, 0); PG8_STAGE(PG8_SA(1, 1), a1 + hstepA, voffA);
            PG8_WAIT_V(8); PG8_WAIT_L(0); PG8_BAR; PG8_MMA(0, 0, At, B0); PG8_MMA(0, 1, At, B1); PG8_BAR; PG8_SCHED;
            PG8_LDA(At, 0, 1); PG8_STAGE(PG8_SB(0, 0), b2, voffB); PG8_STAGE(PG8_SB(0, 1), b2 + hstep, voffB); PG8_STAGE(PG8_SA(0, 0), a2, voffA);
            PG8_WAIT_V(8); PG8_WAIT_L(0); PG8_BAR; PG8_MMA(1, 0, At, B0); PG8_MMA(1, 1, At, B1); PG8_BAR; PG8_SCHED;
            PG8_LDB(B0, 1, 0); PG8_LDB(B1, 1, 1); PG8_SCHED; PG8_LDA(At, 1, 0); PG8_STAGE(PG8_SA(0, 1), a2 + hstepA, voffA);
            PG8_WAIT_V(8); PG8_WAIT_L(0); PG8_BAR; PG8_MMA(0, 0, At, B0); PG8_MMA(0, 1, At, B1); PG8_BAR; PG8_SCHED;
            PG8_LDA(At, 1, 1); PG8_STAGE(PG8_SB(1, 0), b3, voffB); PG8_STAGE(PG8_SB(1, 1), b3 + hstep, voffB); PG8_STAGE(PG8_SA(1, 0), a3, voffA);
            PG8_WAIT_V(8); PG8_WAIT_L(0); PG8_BAR; PG8_MMA(1, 0, At, B0); PG8_MMA(1, 1, At, B1); PG8_BAR; PG8_SCHED;
            } else {
            PG8_LDB(B0, 0, 0); PG8_SCHED; PG8_LDA(At, 0, 0); PG8_STAGE(PG8_SA(1, 1), a1 + hstepA, voffA);
            PG8_WAIT_L(8); PG8_BAR; PG8_WAIT_L(0); PG8_MMA(0, 0, At, B0); PG8_BAR; PG8_SCHED;
            PG8_LDB(B1, 0, 1); PG8_STAGE(PG8_SB(0, 0), b2, voffB);
            PG8_BAR; PG8_WAIT_L(0); PG8_MMA(0, 1, At, B1); PG8_BAR;
            PG8_LDA(At, 0, 1); PG8_STAGE(PG8_SA(0, 0), a2, voffA);
            PG8_BAR; PG8_WAIT_L(0); PG8_MMA(1, 0, At, B0); PG8_BAR; PG8_SCHED;
            PG8_STAGE(PG8_SB(0, 1), b2 + hstep, voffB);
            PG8_WAIT_V(6); PG8_BAR; PG8_MMA(1, 1, At, B1); PG8_BAR;
            PG8_LDB(B0, 1, 0); PG8_SCHED; PG8_LDA(At, 1, 0); PG8_STAGE(PG8_SA(0, 1), a2 + hstepA, voffA);
            PG8_WAIT_L(8); PG8_BAR; PG8_WAIT_L(0); PG8_MMA(0, 0, At, B0); PG8_BAR; PG8_SCHED;
            PG8_LDB(B1, 1, 1); PG8_STAGE(PG8_SB(1, 0), b3, voffB);
            PG8_BAR; PG8_WAIT_L(0); PG8_MMA(0, 1, At, B1); PG8_BAR;
            PG8_LDA(At, 1, 1); PG8_STAGE(PG8_SA(1, 0), a3, voffA);
            PG8_BAR; PG8_WAIT_L(0); PG8_MMA(1, 0, At, B0); PG8_BAR; PG8_SCHED;
            PG8_STAGE(PG8_SB(1, 1), b3 + hstep, voffB);
            PG8_WAIT_V(6); PG8_BAR; PG8_MMA(1, 1, At, B1); PG8_BAR;
            }
        }
        if constexpr (ALIGN_EPI) { if (wr == 0) PG8_BAR; }
        if constexpr (!Epi::AFTER_DRAIN) { E(acc, cur, wr, wc, fr, fq); S.done(cur); }
        if (!has_next) break;
#pragma unroll
        for (int a = 0; a < 2; ++a)
#pragma unroll
            for (int b = 0; b < 2; ++b)
#pragma unroll
                for (int m = 0; m < 4; ++m)
#pragma unroll
                    for (int n = 0; n < 2; ++n) acc[a][b][m][n] = (f32x4){0.f, 0.f, 0.f, 0.f};
        cur = nxt; cA = nA; cB = nB; ++ui;
        if constexpr (ALIGN_EPI) { if (wr == 1) PG8_BAR; }
    }
    PG8_WAIT_V(0);
    if constexpr (!ALIGN_EPI) { if (wr == 0) PG8_BAR; }
    PG8_BAR;
    if constexpr (Epi::AFTER_DRAIN) { E.fused(acc, cur, wr, wc, fr, fq, lds, wid, lane); S.done(cur); }
#undef PG8_SA
#undef PG8_SB
#undef PG8_STAGE
#undef PG8_LDA
#undef PG8_LDB
#undef PG8_MMA
#undef PG8_WAIT_V
#undef PG8_WAIT_L
#undef PG8_BAR
#undef PG8_SCHED
}
}

#define LAS __attribute__((address_space(3)))
typedef unsigned short bf16;
typedef short bf16x8 __attribute__((ext_vector_type(8)));
typedef short s16x4 __attribute__((ext_vector_type(4)));
typedef float f32x4 __attribute__((ext_vector_type(4)));
typedef float f32x16 __attribute__((ext_vector_type(16)));
typedef unsigned u32x4 __attribute__((ext_vector_type(4)));
typedef unsigned u32x2 __attribute__((ext_vector_type(2)));

constexpr int DM = 1024, NB = 16, SEQ = 2048, CTX = 256, DFF = 4096;
constexpr int MLAT = NB * SEQ, MCTX = NB * CTX, MTOT = MLAT + MCTX;
constexpr int NWAVES = 8, NTHR = 512;
constexpr float LN_EPS = 1e-5f, RMS_EPS = 1e-6f, LOG2E = 1.4426950408889634f, L2THETA = 13.287712379549449f;
constexpr size_t MiB = 1u << 20, MEL = 1u << 20;
constexpr size_t W_MLP = 0;
constexpr size_t W_MLA = 32 * MEL;
constexpr size_t W_MLA_STRIDE = 3 * MEL + MEL / 4;
constexpr size_t W_NA = W_MLA + 2 * W_MLA_STRIDE;
constexpr size_t W_GQA = W_NA + 4 * MEL;
constexpr size_t W_END = W_GQA + 2 * MEL + MEL / 2;
constexpr size_t WS_MOD = 90 * MiB, WS_XCTX = 92 * MiB, WS_HA = 108 * MiB, WS_SCR = 180 * MiB, WS_END = 504 * MiB;
static_assert(W_END * 2 == 90 * MiB, "weights");
constexpr int LDS_BYTES = 147456;
constexpr size_t WS_CTL = 91 * MiB + 768 * 1024, CTL_BYTES = 16384;
constexpr int LDS_MISC = 131072 + 64;

__device__ __forceinline__ float bf2f(unsigned short b) { return __uint_as_float((unsigned)b << 16); }
__device__ __forceinline__ unsigned pk2(float lo, float hi) { return pg8::cvt_pk_bf16(lo, hi); }
__device__ __forceinline__ float wave_sum(float v) {
#pragma unroll
    for (int o = 1; o < 64; o <<= 1) v += __shfl_xor(v, o);
    return v;
}

__device__ __forceinline__ void transpose_item(const float* W, int N, bf16* WT, int ldt, int row_off, LAS float* scr, int item, int lane) {
    const int nblk = N / 32, kb = item / nblk, nb = item % nblk, k0 = 64 * kb, n0 = 32 * nb;
#pragma unroll 8
    for (int i = 0; i < 32; ++i) { const int kk = 2 * i + (lane >> 5); scr[kk * 33 + (lane & 31)] = W[(size_t)(k0 + kk) * N + n0 + (lane & 31)]; }
    asm volatile("s_waitcnt lgkmcnt(0)" ::: "memory");
    const int c = lane & 7;
#pragma unroll
    for (int j = 0; j < 4; ++j) { const int n = (lane >> 3) + 8 * j; const LAS float* s = scr + (8 * c) * 33 + n;
        u32x4 o; o.x = pk2(s[0 * 33], s[1 * 33]); o.y = pk2(s[2 * 33], s[3 * 33]); o.z = pk2(s[4 * 33], s[5 * 33]); o.w = pk2(s[6 * 33], s[7 * 33]);
        *(u32x4*)(WT + (size_t)(row_off + n0 + n) * ldt + k0 + 8 * c) = o; }
    asm volatile("s_waitcnt lgkmcnt(0)" ::: "memory");
}

struct Args { const float* in[27]; float* out; unsigned char* ws; };

__device__ __forceinline__ void prologue(const Args& a, LAS unsigned char* lds, int tid, int lane, int wid, int G) {
    bf16* Wb = (bf16*)a.ws;
    float* mod = (float*)(a.ws + WS_MOD);
    {
        LAS float* S = (LAS float*)lds;
        LAS float* Pp = (LAS float*)(lds + 81920);
        for (int o = tid; o < 17 * 1024; o += NTHR) { const int r = o >> 10, k = o & 1023; const float v = r < 16 ? a.in[1][r * 1024 + k] : a.in[3][k]; S[k * 20 + r] = v / (1.f + __expf(-v)); }
        __syncthreads();
        for (int it = blockIdx.x; it < 4 * 96; it += G) {
            const int l = it / 96, cgp = it % 96;
            const float* w = a.in[4] + (size_t)l * 1024 * 6144 + cgp * 64 + lane;
            float acc[17];
#pragma unroll
            for (int r = 0; r < 17; ++r) acc[r] = 0.f;
            const int k0 = wid * 128;
#pragma unroll 4
            for (int k = k0; k < k0 + 128; ++k) {
                const float wv = w[(size_t)k * 6144];
                const LAS f32x4* sp = (const LAS f32x4*)(S + k * 20);
                const f32x4 s0 = sp[0], s1 = sp[1], s2 = sp[2], s3 = sp[3]; const float s4 = S[k * 20 + 16];
                acc[0] += s0[0] * wv; acc[1] += s0[1] * wv; acc[2] += s0[2] * wv; acc[3] += s0[3] * wv;
                acc[4] += s1[0] * wv; acc[5] += s1[1] * wv; acc[6] += s1[2] * wv; acc[7] += s1[3] * wv;
                acc[8] += s2[0] * wv; acc[9] += s2[1] * wv; acc[10] += s2[2] * wv; acc[11] += s2[3] * wv;
                acc[12] += s3[0] * wv; acc[13] += s3[1] * wv; acc[14] += s3[2] * wv; acc[15] += s3[3] * wv; acc[16] += s4 * wv;
            }
#pragma unroll
            for (int r = 0; r < 17; ++r) Pp[(wid * 17 + r) * 64 + lane] = acc[r];
            __syncthreads();
            for (int o = tid; o < 17 * 64; o += NTHR) { const int r = o >> 6, cj = o & 63; float s = 0.f;
#pragma unroll
                for (int kg = 0; kg < 8; ++kg) s += Pp[(kg * 17 + r) * 64 + cj];
                const int col = cgp * 64 + cj; mod[((size_t)l * 17 + r) * 6144 + col] = s + a.in[5][l * 6144 + col]; }
            __syncthreads();
        }
    }
    __syncthreads();
    LAS float* scr = (LAS float*)(lds + wid * 16384);
    const int gw = blockIdx.x * NWAVES + wid, NGW = G * NWAVES;
    for (int mi = 0; mi < 22; ++mi) {
        const float* src; int K, N, ldt, roff; bf16* dst;
        if (mi < 8) { const int l = mi >> 1; if (mi & 1) { src = a.in[11] + (size_t)l * 4 * MEL; K = 4096; N = 1024; dst = Wb + W_MLP + (size_t)l * 8 * MEL + 4 * MEL; } else { src = a.in[10] + (size_t)l * 4 * MEL; K = 1024; N = 4096; dst = Wb + W_MLP + (size_t)l * 8 * MEL; } ldt = K; roff = 0; }
        else if (mi < 18) { const int j = (mi - 8) / 5, w = (mi - 8) % 5; bf16* base = Wb + W_MLA + j * W_MLA_STRIDE;
            if (w == 0) { src = a.in[12] + (size_t)j * 1024 * 512; K = 1024; N = 512; dst = base; ldt = 1024; roff = 0; }
            else if (w == 1) { src = a.in[15] + (size_t)j * 1024 * 320; K = 1024; N = 320; dst = base; ldt = 1024; roff = 512; }
            else if (w == 2) { src = a.in[14] + (size_t)j * 512 * 1536; K = 512; N = 1536; dst = base + MEL; ldt = 512; roff = 0; }
            else if (w == 3) { src = a.in[17] + (size_t)j * 256 * 2048; K = 256; N = 2048; dst = base + MEL + 3 * MEL / 4; ldt = 256; roff = 0; }
            else { src = a.in[18] + (size_t)j * MEL; K = 1024; N = 1024; dst = base + 2 * MEL + MEL / 4; ldt = 1024; roff = 0; } }
        else if (mi == 18) { src = a.in[19]; K = 1024; N = 3072; dst = Wb + W_NA; ldt = 1024; roff = 0; }
        else if (mi == 19) { src = a.in[22]; K = 1024; N = 1024; dst = Wb + W_NA + 3 * MEL; ldt = 1024; roff = 0; }
        else if (mi == 20) { src = a.in[23]; K = 1024; N = 1536; dst = Wb + W_GQA; ldt = 1024; roff = 0; }
        else { src = a.in[26]; K = 1024; N = 1024; dst = Wb + W_GQA + MEL + MEL / 2; ldt = 1024; roff = 0; }
        const int nitems = (K / 64) * (N / 32);
        for (int it = gw; it < nitems; it += NGW) transpose_item(src, N, dst, ldt, roff, scr, it, lane);
    }
    for (int j = 0; j < 2; ++j) { u32x4* z = (u32x4*)(Wb + W_MLA + j * W_MLA_STRIDE + (size_t)832 * 1024); const int n16 = 192 * 1024 * 2 / 16;
        for (int i = blockIdx.x * NTHR + tid; i < n16; i += G * NTHR) z[i] = (u32x4){0u, 0u, 0u, 0u}; }
}

__device__ __forceinline__ void rowpass(const float* slat, const float* sctx, float* xlat, float* xctx, bool do_ln, bool write_x, const float* lg, const float* lb,
                                        const float* modl, int sc_off, int sh_off, bool write_ha, bf16* HA, int nrows, int lane, int wid, int G) {
    const int gw = blockIdx.x * NWAVES + wid, NGW = G * NWAVES;
    for (int row0 = gw * 2; row0 < nrows; row0 += NGW * 2) {
        f32x4 v[2][4];
#pragma unroll
        for (int r = 0; r < 2; ++r) { const int row = row0 + r; const float* sp = row < MLAT ? slat + (size_t)row * DM : sctx + (size_t)(row - MLAT) * DM;
#pragma unroll
            for (int j = 0; j < 4; ++j) v[r][j] = *(const f32x4*)(sp + (64 * j + lane) * 4); }
#pragma unroll
        for (int r = 0; r < 2; ++r) {
            const int row = row0 + r; const bool lat = row < MLAT;
            float* xp = lat ? xlat + (size_t)row * DM : xctx + (size_t)(row - MLAT) * DM;
            if (do_ln) {
                float s = 0.f;
#pragma unroll
                for (int j = 0; j < 4; ++j) s += (v[r][j][0] + v[r][j][1]) + (v[r][j][2] + v[r][j][3]);
                const float mean = wave_sum(s) * (1.f / DM); float s2 = 0.f;
#pragma unroll
                for (int j = 0; j < 4; ++j) { v[r][j] = v[r][j] - mean; s2 += (v[r][j][0] * v[r][j][0] + v[r][j][1] * v[r][j][1]) + (v[r][j][2] * v[r][j][2] + v[r][j][3] * v[r][j][3]); }
                const float rstd = 1.f / sqrtf(wave_sum(s2) * (1.f / DM) + LN_EPS);
#pragma unroll
                for (int j = 0; j < 4; ++j) { const f32x4 g = *(const f32x4*)(lg + (64 * j + lane) * 4), b = *(const f32x4*)(lb + (64 * j + lane) * 4); v[r][j] = v[r][j] * rstd * g + b; }
            }
            if (write_x) {
#pragma unroll
                for (int j = 0; j < 4; ++j) *(f32x4*)(xp + (64 * j + lane) * 4) = v[r][j];
            }
            if (write_ha) {
                const float* mp = modl + (size_t)(lat ? (row >> 11) : 16) * 6144;
#pragma unroll
                for (int j = 0; j < 4; ++j) { const f32x4 sc = *(const f32x4*)(mp + sc_off + (64 * j + lane) * 4), sh = *(const f32x4*)(mp + sh_off + (64 * j + lane) * 4);
                    const f32x4 h = v[r][j] * (sc + 1.f) + sh; u32x2 w; w.x = pk2(h[0], h[1]); w.y = pk2(h[2], h[3]);
                    *(u32x2*)(HA + (size_t)row * DM + (64 * j + lane) * 4) = w; }
            }
        }
    }
}

__device__ __forceinline__ void mla_rownorm(bf16* CQ, const float* qn, const float* kvn, int lane, int wid, int G) {
    const int gw = blockIdx.x * NWAVES + wid, NGW = G * NWAVES;
    for (int row = gw; row < MTOT; row += NGW) {
        bf16* rp = CQ + (size_t)row * 1024;
        const u32x4 qa = *(const u32x4*)(rp + lane * 8); const u32x2 ka = *(const u32x2*)(rp + 512 + lane * 4); const float pe = bf2f(rp[768 + lane]);
        float q[8], k[4];
#pragma unroll
        for (int i = 0; i < 4; ++i) { q[2 * i] = __uint_as_float(qa[i] << 16); q[2 * i + 1] = __uint_as_float(qa[i] & 0xffff0000u); }
#pragma unroll
        for (int i = 0; i < 2; ++i) { k[2 * i] = __uint_as_float(ka[i] << 16); k[2 * i + 1] = __uint_as_float(ka[i] & 0xffff0000u); }
        float sq = 0.f, sk = 0.f;
#pragma unroll
        for (int i = 0; i < 8; ++i) sq += q[i] * q[i];
#pragma unroll
        for (int i = 0; i < 4; ++i) sk += k[i] * k[i];
        const float rq = 1.f / sqrtf(wave_sum(sq) * (1.f / 512.f) + RMS_EPS), rk = 1.f / sqrtf(wave_sum(sk) * (1.f / 256.f) + RMS_EPS);
        const f32x4 g0 = *(const f32x4*)(qn + lane * 8), g1 = *(const f32x4*)(qn + lane * 8 + 4), gk = *(const f32x4*)(kvn + lane * 4);
        u32x4 qo; qo.x = pk2(q[0] * rq * g0[0], q[1] * rq * g0[1]); qo.y = pk2(q[2] * rq * g0[2], q[3] * rq * g0[3]); qo.z = pk2(q[4] * rq * g1[0], q[5] * rq * g1[1]); qo.w = pk2(q[6] * rq * g1[2], q[7] * rq * g1[3]);
        u32x2 ko; ko.x = pk2(k[0] * rk * gk[0], k[1] * rk * gk[1]); ko.y = pk2(k[2] * rk * gk[2], k[3] * rk * gk[3]);
        *(u32x4*)(rp + lane * 8) = qo; *(u32x2*)(rp + 512 + lane * 4) = ko;
        const float other = __shfl_xor(pe, 16);
        if (row < MLAT) {
            const int s = row & (SEQ - 1); const float pos = (float)((lane < 32) ? (s >> 6) : (s & 63));
            const float ang = pos * __builtin_amdgcn_exp2f(-(float)(lane & 15) * (L2THETA / 16.f));
            const float cs = __cosf(ang), sn = __sinf(ang);
            const float o = ((lane >> 4) & 1) ? (other * sn + pe * cs) : (pe * cs - other * sn);
            rp[768 + lane] = (bf16)(pk2(o, 0.f) & 0xffffu);
        }
    }
}

__device__ __forceinline__ void gqa_qkpass(bf16* QKV, const float* qn, const float* kn, int lane, int wid, int G) {
    const int gw = blockIdx.x * NWAVES + wid, NGW = G * NWAVES;
    const int j = lane & 15, sub = lane >> 4;
    const bool second = (j & 4) != 0, colhalf = j >= 8;
    const f32x4 gq0 = *(const f32x4*)(qn + 8 * j), gq1 = *(const f32x4*)(qn + 8 * j + 4), gk0 = *(const f32x4*)(kn + 8 * j), gk1 = *(const f32x4*)(kn + 8 * j + 4);
    float fr[8];
#pragma unroll
    for (int e = 0; e < 8; ++e) fr[e] = __builtin_amdgcn_exp2f(-(float)(8 * (j & 3) + e) * (L2THETA / 32.f));
    for (int it = gw; it < MTOT * 3; it += NGW) {
        const int row = it / 3, hh = (it - row * 3) * 4 + sub;
        const bool act = hh < 10;
        bf16* p = QKV + (size_t)row * 1536 + (act ? hh : 0) * 128 + 8 * j;
        const u32x4 raw = *(const u32x4*)p;
        float x[8];
#pragma unroll
        for (int i = 0; i < 4; ++i) { x[2 * i] = __uint_as_float(raw[i] << 16); x[2 * i + 1] = __uint_as_float(raw[i] & 0xffff0000u); }
        float ss = 0.f;
#pragma unroll
        for (int e = 0; e < 8; ++e) ss += x[e] * x[e];
        ss += __shfl_xor(ss, 1); ss += __shfl_xor(ss, 2); ss += __shfl_xor(ss, 4); ss += __shfl_xor(ss, 8);
        const float rstd = 1.f / sqrtf(ss * (1.f / 128.f) + RMS_EPS);
        const bool isq = hh < 8;
#pragma unroll
        for (int e = 0; e < 8; ++e) { const float g = e < 4 ? (isq ? gq0[e & 3] : gk0[e & 3]) : (isq ? gq1[e & 3] : gk1[e & 3]); x[e] *= rstd * g; }
        float y[8];
#pragma unroll
        for (int e = 0; e < 8; ++e) y[e] = __shfl_xor(x[e], 4);
        if (row < MLAT) {
            const int s = row & (SEQ - 1); const float pos = (float)(colhalf ? (s & 63) : (s >> 6));
#pragma unroll
            for (int e = 0; e < 8; ++e) { const float ang = pos * fr[e]; const float cs = __cosf(ang), sn = __sinf(ang);
                x[e] = second ? (y[e] * sn + x[e] * cs) : (x[e] * cs - y[e] * sn); }
        }
        if (act) { u32x4 w; w.x = pk2(x[0], x[1]); w.y = pk2(x[2], x[3]); w.z = pk2(x[4], x[5]); w.w = pk2(x[6], x[7]); *(u32x4*)p = w; }
    }
}
__device__ __forceinline__ void mla_qrope(bf16* Qb, int lane, int wid, int G) {
    const int gw = blockIdx.x * NWAVES + wid, NGW = G * NWAVES;
    const int hd = lane >> 3, half = (lane >> 2) & 1, i0 = 4 * (lane & 3);
    float fr[4];
#pragma unroll
    for (int i = 0; i < 4; ++i) fr[i] = __builtin_amdgcn_exp2f(-(float)(i0 + i) * (L2THETA / 16.f));
    for (int row = gw; row < MLAT; row += NGW) {
        bf16* p = Qb + (size_t)row * 1536 + hd * 192 + 128 + 32 * half + i0;
        const u32x2 a = *(const u32x2*)p, b = *(const u32x2*)(p + 16);
        const int s = row & (SEQ - 1); const float pos = (float)(half == 0 ? (s >> 6) : (s & 63));
        float x1[4], x2[4], o1[4], o2[4];
        x1[0] = __uint_as_float(a.x << 16); x1[1] = __uint_as_float(a.x & 0xffff0000u); x1[2] = __uint_as_float(a.y << 16); x1[3] = __uint_as_float(a.y & 0xffff0000u);
        x2[0] = __uint_as_float(b.x << 16); x2[1] = __uint_as_float(b.x & 0xffff0000u); x2[2] = __uint_as_float(b.y << 16); x2[3] = __uint_as_float(b.y & 0xffff0000u);
#pragma unroll
        for (int i = 0; i < 4; ++i) { const float ang = pos * fr[i]; const float cs = __cosf(ang), sn = __sinf(ang); o1[i] = x1[i] * cs - x2[i] * sn; o2[i] = x1[i] * sn + x2[i] * cs; }
        u32x2 wa, wb; wa.x = pk2(o1[0], o1[1]); wa.y = pk2(o1[2], o1[3]); wb.x = pk2(o2[0], o2[1]); wb.y = pk2(o2[2], o2[3]);
        *(u32x2*)p = wa; *(u32x2*)(p + 16) = wb;
    }
}

struct AttnP { const bf16* Q; int ldq; const bf16* K; int ldk; const bf16* K2; int ldk2; const bf16* V; int ldv; bf16* O; const float* gq; const float* rpb; };
typedef LAS const char* lds_cptr;
typedef short v4i16_t __attribute__((ext_vector_type(4)));
__device__ __forceinline__ s16x4 vtr(lds_cptr p) { return __builtin_bit_cast(s16x4, __builtin_amdgcn_ds_read_tr16_b64_v4i16((LAS v4i16_t*)p)); }
__device__ __forceinline__ int crow(int r, int hi) { return (r & 3) + 8 * (r >> 2) + 4 * hi; }

template <int MODE>
__device__ __forceinline__ void attn_unit(const AttnP& P, int b, int h, int qb, bool isctx, LAS unsigned char* lds, int tid, int lane, int wid) {
    constexpr int DK = MODE == 0 ? 192 : (MODE == 1 ? 64 : 128), DV = MODE == 1 ? 64 : 128;
    constexpr int KSTR = DK * 2 + 16, VSTR = DV * 2 + 64, VOFF = 64 * KSTR, TILEB = 64 * (KSTR + VSTR);
    constexpr int NKD = DK / 16, NDB = DV / 32;
    constexpr int KC = MODE == 1 ? 1 : 2, VC = MODE == 1 ? 1 : 2, CSH = MODE == 1 ? 3 : 4, CMASK = MODE == 1 ? 7 : 15;
    constexpr float SC = (MODE == 0 ? 0.07216878364870322f : (MODE == 1 ? 0.125f : 0.08838834764831845f)) * LOG2E;
    const int r32 = lane & 31, hi = lane >> 5;
    const int qloc = wid * 32 + r32;
    const size_t qg = isctx ? (size_t)(MLAT + b * CTX + qloc) : (size_t)b * SEQ + qb * 256 + qloc;
    const int spos = qb * 256 + qloc;
    const int qoff = MODE == 0 ? h * 192 : (MODE == 1 ? h * 64 : h * 128);
    const int koff = MODE == 0 ? h * 256 : (MODE == 1 ? 1024 + h * 64 : 1024 + (h >> 2) * 128);
    const int voff = MODE == 0 ? h * 256 + 128 : (MODE == 1 ? 2048 + h * 64 : 1280 + (h >> 2) * 128);
    const int ooff = MODE == 1 ? h * 64 : h * 128;
    bf16x8 qf[NKD];
    { const bf16* qp = P.Q + qg * P.ldq + qoff + hi * 8;
#pragma unroll
      for (int d0 = 0; d0 < NKD; ++d0) qf[d0] = *(const bf16x8*)(qp + d0 * 16); }
    int kr_lo = 0, NT = isctx ? 4 : 36, rs_w = 0, rq = 0;
    if constexpr (MODE == 1) {
        if (!isctx) { const int R0 = qb * 4; const int lo = min(max(R0 - 4, 0), 24), hiw = min(max(R0 + 3 - 4, 0), 24) + 7; kr_lo = lo; NT = 4 + (hiw - lo + 1);
            rq = R0 + (wid >> 1); rs_w = min(max(rq - 4, 0), 24); }
        LAS float* rl = (LAS float*)(lds + 2 * TILEB);
        if (tid < 465) rl[tid] = P.rpb[h * 465 + tid] * LOG2E;
    }
    const size_t ctx_base = (size_t)MLAT + (size_t)b * CTX, lat_base = (size_t)b * SEQ;
    u32x4 kreg[KC], vreg[VC], k2reg;
#define ATT_TROW(t) ((t) < 4 ? ctx_base + (size_t)(t) * 64 : lat_base + (size_t)(kr_lo + (t) - 4) * 64)
#define ATT_LOAD(t) do { const size_t trow_ = ATT_TROW(t); \
        _Pragma("unroll") for (int i_ = 0; i_ < KC; ++i_) { const int c_ = tid + NTHR * i_; kreg[i_] = *(const u32x4*)(P.K + (trow_ + (c_ >> CSH)) * P.ldk + koff + (c_ & CMASK) * 8); } \
        if constexpr (MODE == 0) k2reg = *(const u32x4*)(P.K2 + (trow_ + (tid >> 3)) * P.ldk2 + (tid & 7) * 8); \
        _Pragma("unroll") for (int i_ = 0; i_ < VC; ++i_) { const int c_ = tid + NTHR * i_; vreg[i_] = *(const u32x4*)(P.V + (trow_ + (c_ >> CSH)) * P.ldv + voff + (c_ & CMASK) * 8); } } while (0)
    ATT_LOAD(0);
    float m_run = -1e30f, l_run = 0.f;
    f32x16 o[NDB];
#pragma unroll
    for (int d = 0; d < NDB; ++d) o[d] = f32x16{};
    const lds_cptr lds3 = (lds_cptr)lds;
    const int kbase_off = r32 * KSTR + hi * 16;
    const int vbase_off = VOFF + (4 * hi + ((lane & 15) >> 2)) * VSTR + (((lane >> 4) & 1) * 16 + (lane & 3) * 4) * 2;
    for (int t = 0; t < NT; ++t) {
        LAS unsigned char* buf = lds + (t & 1) * TILEB;
#pragma unroll
        for (int i = 0; i < KC; ++i) { const int c = tid + NTHR * i; *(LAS u32x4*)(buf + (c >> CSH) * KSTR + (c & CMASK) * 16) = kreg[i]; }
        if constexpr (MODE == 0) *(LAS u32x4*)(buf + (tid >> 3) * KSTR + 256 + (tid & 7) * 16) = k2reg;
#pragma unroll
        for (int i = 0; i < VC; ++i) { const int c = tid + NTHR * i; *(LAS u32x4*)(buf + VOFF + (c >> CSH) * VSTR + (c & CMASK) * 16) = vreg[i]; }
        __syncthreads();
        if (t + 1 < NT) ATT_LOAD(t + 1);
        bool active = true; int kr = 0;
        if constexpr (MODE == 1) { if (t >= 4) { kr = kr_lo + t - 4; active = (kr >= rs_w) && (kr < rs_w + 8); } }
        if (active) {
            const lds_cptr kb3 = lds3 + (t & 1) * TILEB + kbase_off;
            f32x16 s0 = f32x16{}, s1 = f32x16{};
#pragma unroll
            for (int d0 = 0; d0 < NKD; ++d0) {
                const bf16x8 k0 = *(const LAS bf16x8*)(kb3 + d0 * 32), k1 = *(const LAS bf16x8*)(kb3 + 32 * KSTR + d0 * 32);
                s0 = __builtin_amdgcn_mfma_f32_32x32x16_bf16(k0, qf[d0], s0, 0, 0, 0);
                s1 = __builtin_amdgcn_mfma_f32_32x32x16_bf16(k1, qf[d0], s1, 0, 0, 0);
                if ((d0 & 3) == 3) __builtin_amdgcn_sched_barrier(0);
            }
            float mx;
            if constexpr (MODE == 1) {
                if (t >= 4) {
                    const int c = (wid & 1) * 32 + r32, cst = min(max(c - 8, 0), 48);
                    const LAS float* rl = (const LAS float*)(lds + 2 * TILEB) + (kr - rq + 7) * 31 + 15 - c;
#pragma unroll
                    for (int r = 0; r < 16; ++r) { const int kc0 = crow(r, hi), kc1 = kc0 + 32;
                        const bool v0 = (kc0 >= cst) && (kc0 < cst + 16), v1 = (kc1 >= cst) && (kc1 < cst + 16);
                        const float b0 = rl[v0 ? kc0 : c], b1 = rl[v1 ? kc1 : c];
                        s0[r] = v0 ? s0[r] * SC + b0 : -1e30f; s1[r] = v1 ? s1[r] * SC + b1 : -1e30f; }
                } else {
#pragma unroll
                    for (int r = 0; r < 16; ++r) { s0[r] *= SC; s1[r] *= SC; }
                }
            }
            mx = fmaxf(s0[0], s1[0]);
#pragma unroll
            for (int r = 1; r < 16; ++r) mx = fmaxf(mx, fmaxf(s0[r], s1[r]));
            mx = fmaxf(mx, __shfl_xor(mx, 32));
            if constexpr (MODE != 1) mx *= SC;
            const float m_new = fmaxf(m_run, mx);
            const float alpha = __builtin_amdgcn_exp2f(m_run - m_new); m_run = m_new;
            float ps = 0.f;
#pragma unroll
            for (int r = 0; r < 16; ++r) {
                if constexpr (MODE == 1) { s0[r] = __builtin_amdgcn_exp2f(s0[r] - m_new); s1[r] = __builtin_amdgcn_exp2f(s1[r] - m_new); }
                else { s0[r] = __builtin_amdgcn_exp2f(s0[r] * SC - m_new); s1[r] = __builtin_amdgcn_exp2f(s1[r] * SC - m_new); }
                ps += s0[r] + s1[r];
            }
            l_run = l_run * alpha + ps;
#pragma unroll
            for (int d = 0; d < NDB; ++d) o[d] = o[d] * alpha;
            u32x4 pw[2][2];
#pragma unroll
            for (int ks = 0; ks < 2; ++ks) {
                pw[0][ks] = (u32x4){pk2(s0[8 * ks], s0[8 * ks + 1]), pk2(s0[8 * ks + 2], s0[8 * ks + 3]), pk2(s0[8 * ks + 4], s0[8 * ks + 5]), pk2(s0[8 * ks + 6], s0[8 * ks + 7])};
                pw[1][ks] = (u32x4){pk2(s1[8 * ks], s1[8 * ks + 1]), pk2(s1[8 * ks + 2], s1[8 * ks + 3]), pk2(s1[8 * ks + 4], s1[8 * ks + 5]), pk2(s1[8 * ks + 6], s1[8 * ks + 7])};
            }
            const lds_cptr vb3 = lds3 + (t & 1) * TILEB + vbase_off;
#pragma unroll
            for (int d = 0; d < NDB; ++d)
#pragma unroll
                for (int kb = 0; kb < 2; ++kb)
#pragma unroll
                    for (int ks = 0; ks < 2; ++ks) {
                        const s16x4 lo = vtr(vb3 + (32 * kb + 16 * ks) * VSTR + d * 64), hh = vtr(vb3 + (32 * kb + 16 * ks + 8) * VSTR + d * 64);
                        const bf16x8 vf = (bf16x8){lo[0], lo[1], lo[2], lo[3], hh[0], hh[1], hh[2], hh[3]};
                        o[d] = __builtin_amdgcn_mfma_f32_32x32x16_bf16(vf, __builtin_bit_cast(bf16x8, pw[kb][ks]), o[d], 0, 0, 0);
                        if (kb == 1 && ks == 1) __builtin_amdgcn_sched_barrier(0);
                    }
        }
    }
#undef ATT_LOAD
#undef ATT_TROW
    l_run += __shfl_xor(l_run, 32);
    const float inv = 1.f / l_run;
    bf16* op = P.O + qg * DM + ooff + 4 * hi;
#pragma unroll
    for (int d = 0; d < NDB; ++d)
#pragma unroll
        for (int g = 0; g < 4; ++g) { u32x2 w; w.x = pk2(o[d][4 * g] * inv, o[d][4 * g + 1] * inv); w.y = pk2(o[d][4 * g + 2] * inv, o[d][4 * g + 3] * inv);
            *(u32x2*)(op + d * 32 + g * 8) = w; }
    __syncthreads();
}

template <int MODE>
__device__ __forceinline__ void attn_phase(const AttnP& P, bool need_ctx, LAS unsigned char* lds, int tid, int lane, int wid, int G) {
    constexpr int NH = MODE == 1 ? 16 : 8;
    const int bx = blockIdx.x; const int vcu = (G % 8 == 0) ? (bx % 8) * (G / 8) + bx / 8 : bx;
    const int nlat = NB * NH * 8, nctx = need_ctx ? NB * NH : 0;
    for (int u = vcu; u < nlat + nctx; u += G) {
        if (u < nlat) { const int qb = u & 7, bh = u >> 3; attn_unit<MODE>(P, bh / NH, bh % NH, qb, false, lds, tid, lane, wid); }
        else { const int bh = u - nlat; attn_unit<MODE>(P, bh / NH, bh % NH, 0, true, lds, tid, lane, wid); }
    }
}


#define XB_TMO      128
#define XB_XCNT(j)  (256  + 64 * (j))
#define XB_XSUB(j)  (1280 + 64 * (j))
#define XB_XGEN(j)  (2304 + 64 * (j))
#define XB_TOP      3328
#define XB_TOPGEN   3392
#define XCD_BAR_WORDS 3456
#define XB_SPIN_CAP (1u << 18)

__device__ __forceinline__ unsigned xb_ld(unsigned* p)              { return __hip_atomic_load(p, __ATOMIC_RELAXED, __HIP_MEMORY_SCOPE_AGENT); }
__device__ __forceinline__ unsigned xb_add(unsigned* p, unsigned v) { return __hip_atomic_fetch_add(p, v, __ATOMIC_RELAXED, __HIP_MEMORY_SCOPE_AGENT); }
__device__ __forceinline__ unsigned xb_xcc_id() { return (unsigned)__builtin_amdgcn_s_getreg((3 << 11) | 20) & 0xFu; }
#define XB_SPIN(cond, bar) do { unsigned _sp = 0; while (cond) { __builtin_amdgcn_s_sleep(1); \
    if ((++_sp & 255u) == 0u) { if (xb_ld(&(bar)[XB_TMO])) break; if (_sp > XB_SPIN_CAP) { atomicAdd(&(bar)[XB_TMO], 1u); break; } } } } while (0)

struct XcdBarrier {
    unsigned* bar; unsigned x;
    volatile LAS unsigned* st;
};

__device__ __forceinline__ XcdBarrier xcd_barrier_post(unsigned* bar, volatile LAS unsigned* st) {
    XcdBarrier b; b.bar = bar; b.x = xb_xcc_id(); b.st = st;
    if (threadIdx.x == 0) (void)xb_add(&bar[XB_XCNT(b.x)], 1u);
    return b;
}
__device__ __forceinline__ void xcd_barrier_complete(unsigned* bar, unsigned x, unsigned& nloc, unsigned& nx) {
    const unsigned G = gridDim.x * gridDim.y * gridDim.z;
    unsigned sum, cnt, mine, sp = 0u;
    for (;;) {
        sum = 0u; cnt = 0u; mine = 0u;
#pragma unroll
        for (unsigned j = 0; j < 16; ++j) { const unsigned c = xb_ld(&bar[XB_XCNT(j)]); sum += c; cnt += (c > 0u) ? 1u : 0u; mine = (j == x) ? c : mine; }
        if (sum == G) break;
        __builtin_amdgcn_s_sleep(1);
        if ((++sp & 255u) == 0u) { if (xb_ld(&bar[XB_TMO])) break; if (sp > XB_SPIN_CAP) { atomicAdd(&bar[XB_TMO], 1u); break; } }
    }
    nloc = mine > 0u ? mine : 1u; nx = cnt > 0u ? cnt : 1u;
}

__device__ __forceinline__ void xcd_barrier(const XcdBarrier& b) {
    asm volatile("s_waitcnt vmcnt(0)" ::: "memory");
    __syncthreads();
    if (threadIdx.x == 0) {
        unsigned* bar = b.bar;
        __builtin_amdgcn_s_waitcnt(0);
        unsigned nloc = b.st[0], nx = b.st[1];
        if (nloc == 0u) { xcd_barrier_complete(bar, b.x, nloc, nx); b.st[0] = nloc; b.st[1] = nx; }
        const unsigned old = xb_add(&bar[XB_XSUB(b.x)], 1u);
        const unsigned gen = old / nloc;
        if (old + 1u == (gen + 1u) * nloc) {
            __builtin_amdgcn_fence(__ATOMIC_RELEASE, "agent");
            asm volatile("s_waitcnt vmcnt(0)" ::: "memory");
            const unsigned og = xb_add(&bar[XB_TOP], 1u);
            const unsigned tg = og / nx;
            if (og + 1u == (tg + 1u) * nx) xb_add(&bar[XB_TOPGEN], 1u);
            else XB_SPIN(xb_ld(&bar[XB_TOPGEN]) == tg, bar);
            __builtin_amdgcn_fence(__ATOMIC_ACQUIRE, "agent");
            xb_add(&bar[XB_XGEN(b.x)], 1u);
            asm volatile("s_waitcnt vmcnt(0)" ::: "memory");
        } else {
            XB_SPIN(xb_ld(&bar[XB_XGEN(b.x)]) == gen, bar);
            __builtin_amdgcn_fence(__ATOMIC_ACQUIRE, "agent");
            asm volatile("s_waitcnt vmcnt(0)" ::: "memory");
        }
    }
    __syncthreads();
}

__global__ void __launch_bounds__(NTHR, 2) mega_fwd(Args a) {
    extern __shared__ __attribute__((aligned(16))) unsigned char lds_raw[];
    LAS unsigned char* lds = (LAS unsigned char*)lds_raw;
    cg::grid_group grid = cg::this_grid();
    const int tid = threadIdx.x, lane = tid & 63, wid = __builtin_amdgcn_readfirstlane(tid >> 6), G = gridDim.x;
    unsigned char* ws = a.ws;
    bf16* Wb = (bf16*)ws; float* mod = (float*)(ws + WS_MOD); float* xctx = (float*)(ws + WS_XCTX); float* xlat = a.out;
    bf16* HA = (bf16*)(ws + WS_HA); bf16* SCR = (bf16*)(ws + WS_SCR);
    const float alpha = 1.681792830507429f;
    volatile LAS unsigned* bst = (volatile LAS unsigned*)(lds + LDS_MISC);
    if (threadIdx.x < 2) bst[threadIdx.x] = 0u;
    __syncthreads();
    XcdBarrier bar = xcd_barrier_post((unsigned*)(ws + WS_CTL), bst);

#ifndef T_NOPRO
    prologue(a, lds, tid, lane, wid, G);
#endif
#ifdef PROBE_PRO2
    grid.sync();
    prologue(a, lds, tid, lane, wid, G);
#endif
    grid.sync();
    rowpass(a.in[0], a.in[2], xlat, xctx, false, false, nullptr, nullptr, mod, 1024, 0, true, HA, MTOT, lane, wid, G);
    xcd_barrier(bar);

    for (int layer = 0; layer < 4; ++layer) {
        const int kind = layer % 3, j = layer / 3;
        const bool need_ctx = layer < 3;
        const int Mx = need_ctx ? MTOT : MLAT;
        const float* modl = mod + (size_t)layer * 17 * 6144;
        const int head = kind == 0 ? 6 : (kind == 1 ? 2 : 3);
#ifdef PROBE_REP
        int probe_done = 0;
#endif
        for (int op = 0; op < head + 5; ++op) {
            int tid = threadIdx.x; asm volatile("" : "+v"(tid)); const int lane = tid & 63;
            int type = 0; bool sync_after = true;
            pg8::Gemm g{nullptr, 0, nullptr, 0, 0, 0}; pg8::EpiBf16 eb{nullptr, 0, nullptr, 0}; int goff = 0; int lnsub = 0;
            if (op < head) {
                if (kind == 0) {
                    bf16* base = Wb + W_MLA + j * W_MLA_STRIDE; bf16* CQ = SCR; bf16* Qb = SCR + (size_t)MTOT * 1024; bf16* KV = Qb + (size_t)MTOT * 1536;
                    if (op == 0) { g = pg8::Gemm{HA, 1024, base, MTOT, 1024, 1024}; eb = pg8::EpiBf16{CQ, 1024, nullptr, 0}; }
                    else if (op == 1) type = 3;
                    else if (op == 2) { g = pg8::Gemm{CQ, 1024, base + MEL, Mx, 1536, 512}; eb = pg8::EpiBf16{Qb, 1536, nullptr, 0}; sync_after = false; }
                    else if (op == 3) { g = pg8::Gemm{CQ + 512, 1024, base + MEL + 3 * MEL / 4, MTOT, 2048, 256}; eb = pg8::EpiBf16{KV, 2048, nullptr, 0}; }
                    else if (op == 4) type = 6;
                    else type = 2;
                } else if (kind == 1) {
                    if (op == 0) { g = pg8::Gemm{HA, 1024, Wb + W_NA, MTOT, 3072, 1024}; eb = pg8::EpiBf16{SCR, 3072, a.in[20], 0}; }
                    else type = 2;
                } else {
                    if (op == 0) { g = pg8::Gemm{HA, 1024, Wb + W_GQA, MTOT, 1536, 1024}; eb = pg8::EpiBf16{SCR, 1536, nullptr, 0}; }
                    else if (op == 1) type = 4;
                    else type = 2;
                }
            } else {
                const int to = op - head;
                if (to == 0) { type = 1; const bf16* wo = kind == 0 ? Wb + W_MLA + j * W_MLA_STRIDE + 2 * MEL + MEL / 4 : (kind == 1 ? Wb + W_NA + 3 * MEL : Wb + W_GQA + MEL + MEL / 2);
                    g = pg8::Gemm{HA, 1024, wo, Mx, 1024, 1024}; goff = 2048; }
                else if (to == 1) { type = 5; lnsub = 0; }
                else if (to == 2) { g = pg8::Gemm{HA, 1024, Wb + W_MLP + (size_t)layer * 8 * MEL, Mx, 4096, 1024}; eb = pg8::EpiBf16{SCR, 4096, nullptr, 1}; }
                else if (to == 3) { type = 1; g = pg8::Gemm{SCR, 4096, Wb + W_MLP + (size_t)layer * 8 * MEL + 4 * MEL, Mx, 1024, 4096}; goff = 5120; }
                else { type = 5; lnsub = 1; }
            }
#ifndef T_NOGEMM
            if (type == 0) {
                pg8::StaticOrder S; S.init(g.M, g.N, G, (int)blockIdx.x);
                pg8::gemm_phase<pg8::EpiBf16, pg8::StaticOrder, true, true>(lds, g, S, eb);
            } else if (type == 1) {
#ifdef PROBE_T1
                { pg8::StaticOrder S0; S0.init(g.M, g.N, G, (int)blockIdx.x); pg8::EpiBf16 ed{g.A == HA ? SCR : HA, 1024, nullptr, 0};
                  pg8::gemm_phase<pg8::EpiBf16, pg8::StaticOrder, true, true>(lds, g, S0, ed); xcd_barrier(bar); }
#endif
                pg8::StaticOrder S; S.init(g.M, g.N, G, (int)blockIdx.x);
                const bool first_ = (layer == 0 && goff == 2048);
                pg8::EpiResid er{first_ ? a.in[0] : xlat, first_ ? a.in[2] : xctx, xlat, xctx, modl + goff, alpha};
                pg8::gemm_phase<pg8::EpiResid, pg8::StaticOrder, true, true>(lds, g, S, er);
            } else
#endif
            if (type == 2) {
                if (kind == 0) { bf16* CQ = SCR; bf16* Qb = SCR + (size_t)MTOT * 1024; bf16* KV = Qb + (size_t)MTOT * 1536;
                    AttnP P{Qb, 1536, KV, 2048, CQ + 768, 1024, KV, 2048, HA, nullptr, nullptr};
#ifndef T_NOA0
attn_phase<0>(P, need_ctx, lds, tid, lane, wid, G);
#endif
 }
                else if (kind == 1) { AttnP P{SCR, 3072, SCR, 3072, nullptr, 0, SCR, 3072, HA, nullptr, a.in[21]};
#ifndef T_NOA1
attn_phase<1>(P, need_ctx, lds, tid, lane, wid, G);
#endif
 }
                else { AttnP P{SCR, 1536, SCR, 1536, nullptr, 0, SCR, 1536, HA, a.in[24], nullptr};
#ifndef T_NOA2
attn_phase<2>(P, need_ctx, lds, tid, lane, wid, G);
#endif
 }
            } else if (type == 3) {
                mla_rownorm(SCR, a.in[13] + j * 512, a.in[16] + j * 256, lane, wid, G);
            } else if (type == 4) {
                gqa_qkpass(SCR, a.in[24], a.in[25], lane, wid, G);
            } else if (type == 6) {
                mla_qrope(SCR + (size_t)MTOT * 1024, lane, wid, G);
            } else {
                if (lnsub == 0) rowpass(xlat, xctx, xlat, xctx, true, true, a.in[6] + layer * DM, a.in[7] + layer * DM, modl, 4096, 3072, true, HA, Mx, lane, wid, G);
                else { const bool last = layer == 3; rowpass(xlat, xctx, xlat, xctx, true, true, a.in[8] + layer * DM, a.in[9] + layer * DM, modl + 17 * 6144, 1024, 0, !last, HA, Mx, lane, wid, G); }
            }
            if (sync_after && !(layer == 3 && op == head + 4)) { xcd_barrier(bar);
#ifdef PROBE_SYNC2
                xcd_barrier(bar);
#endif
            }
#ifdef PROBE_REP
            if (type == PROBE_REP && !(probe_done & 1)) { probe_done |= 1; --op; } else probe_done = 0;
#endif
        }
    }
}

extern "C" void kernel_launch(void* const* d_in, const int* in_sizes, int n_in, void* d_out, int out_size, void* d_ws, size_t ws_size, hipStream_t stream) {
    static int grid_blocks = 0;
    if (grid_blocks == 0) {
        if (n_in != 27 || out_size != MLAT * DM || ws_size < WS_END) { fprintf(stderr, "kernel_launch: unexpected shapes (n_in %d, out %d, ws %zu)\n", n_in, out_size, ws_size); grid_blocks = -1; return; }
        int dev = 0, cus = 0, per_cu = 0;
        hipGetDevice(&dev);
        hipDeviceGetAttribute(&cus, hipDeviceAttributeMultiprocessorCount, dev);
        hipFuncSetAttribute((const void*)mega_fwd, hipFuncAttributeMaxDynamicSharedMemorySize, LDS_BYTES);
        hipOccupancyMaxActiveBlocksPerMultiprocessor(&per_cu, (const void*)mega_fwd, NTHR, LDS_BYTES);
        if (per_cu < 1) per_cu = 1;
        grid_blocks = cus * per_cu;
    }
    if (grid_blocks < 0) return;
    if (hipMemsetAsync((char*)d_ws + WS_CTL, 0, CTL_BYTES, stream) != hipSuccess) { fprintf(stderr, "kernel_launch: memset failed\n"); return; }
    Args a{};
    for (int i = 0; i < 27; ++i) a.in[i] = (const float*)d_in[i];
    a.out = (float*)d_out; a.ws = (unsigned char*)d_ws;
    void* args[] = {&a};
    hipError_t e = hipLaunchCooperativeKernel((const void*)mega_fwd, dim3(grid_blocks), dim3(NTHR), args, LDS_BYTES, stream);
    if (e != hipSuccess) fprintf(stderr, "cooperative launch failed: %s (grid %d)\n", hipGetErrorString(e), grid_blocks);
}
```
